# Optimizing an MI355X kernel written in HIP

```python
import math
import jax, jax.numpy as jnp
from jax import lax
import numpy as np

D_MODEL = 1024
BATCH = 8
SEQ = 8192
DEPTH = 2

ATTN_WIDTH = D_MODEL // 2
HGRN_WIDTH = D_MODEL - ATTN_WIDTH
HEAD_DIM = 64
N_ATTN_HEADS = ATTN_WIDTH // HEAD_DIM
HGRN_EXPAND = 128
N_HGRN_HEADS = HGRN_WIDTH // HGRN_EXPAND
HGRN_HEAD_DIM = HGRN_WIDTH // N_HGRN_HEADS
DILATED_CONFIGS = ((128, 1), (512, 4), (2048, 16))
ATTN_BLOCK = 128
ROPE_THETA = 500000.0
ROPE_DIM = HEAD_DIM // 4
HGRN_CHUNK = 64
D_FF = 2816
FFN_RES_WEIGHT = 0.5
DEEPNORM_ALPHA = (2 * DEPTH) ** 0.25
DEEPNORM_BETA = (8 * DEPTH) ** -0.25
LN_EPS = 1e-5
RMS_EPS = 1e-6
N_SUBLAYERS = 3
IN_SPLITS = [int(s) for s in np.cumsum([ATTN_WIDTH] * 3 + [HGRN_WIDTH] * 3)]
IN_COLS = 3 * ATTN_WIDTH + 4 * HGRN_WIDTH

kernel_name = 'hybrid_dilated_attn_hgrn2_macaron'


def layer_norm(x, g, b):
    xf = x.astype(jnp.float32)
    mu = jnp.mean(xf, axis=-1, keepdims=True)
    var = jnp.mean(jnp.square(xf - mu), axis=-1, keepdims=True)
    return ((xf - mu) * lax.rsqrt(var + LN_EPS) * g + b).astype(x.dtype)


def modulate(x, shift, scale):
    return x * (1 + scale[:, None, :]) + shift[:, None, :]


def swiglu_ffn(h, w_in, w_out):
    g, u = jnp.split(h @ w_in, 2, axis=-1)
    return (jax.nn.silu(g) * u) @ w_out


def partial_rope(t, pos):
    half = ROPE_DIM // 2
    inv_freq = ROPE_THETA ** (-jnp.arange(half, dtype=jnp.float32) * 2.0 / ROPE_DIM)
    ang = pos.astype(jnp.float32)[:, None, :, None] * inv_freq
    cos = jnp.cos(ang).astype(t.dtype)
    sin = jnp.sin(ang).astype(t.dtype)
    t1, t2, rest = t[..., :half], t[..., half:ROPE_DIM], t[..., ROPE_DIM:]
    return jnp.concatenate([t1 * cos - t2 * sin, t2 * cos + t1 * sin, rest], axis=-1)


def dilated_branch(q, k, v, window, dilation):
    B, H, S, hd = q.shape
    L = S // dilation
    wm = window // dilation
    nb = -(-L // ATTN_BLOCK)
    lp = nb * ATTN_BLOCK

    def res_view(t):
        return t.reshape(B, H, L, dilation, hd).transpose(0, 1, 3, 2, 4)

    qr = jnp.pad(res_view(q), ((0, 0), (0, 0), (0, 0), (0, lp - L), (0, 0)))
    kr = jnp.pad(res_view(k), ((0, 0), (0, 0), (0, 0), (ATTN_BLOCK, lp - L), (0, 0)))
    vr = jnp.pad(res_view(v), ((0, 0), (0, 0), (0, 0), (ATTN_BLOCK, lp - L), (0, 0)))

    def banded(t):
        prev = t[..., :lp, :].reshape(B, H, dilation, nb, ATTN_BLOCK, hd)
        cur = t[..., ATTN_BLOCK:, :].reshape(B, H, dilation, nb, ATTN_BLOCK, hd)
        return jnp.concatenate([prev, cur], axis=-2)

    kb, vb = banded(kr), banded(vr)
    qb = qr.reshape(B, H, dilation, nb, ATTN_BLOCK, hd)
    s = jnp.einsum('bhrnqe,bhrnke->bhrnqk', qb, kb, preferred_element_type=jnp.float32)
    qi = jnp.arange(ATTN_BLOCK)[:, None] + ATTN_BLOCK
    ki = jnp.arange(2 * ATTN_BLOCK)[None, :]
    dist = qi - ki
    key_m = jnp.arange(nb)[:, None, None] * ATTN_BLOCK - ATTN_BLOCK + ki[None]
    mask = (dist >= 0) & (dist <= wm) & (key_m >= 0)
    s = jnp.where(mask, s, -jnp.inf)
    mx = jnp.max(s, axis=-1, keepdims=True)
    p = jnp.exp(s - mx)
    den = jnp.sum(p, axis=-1, keepdims=True)
    o = jnp.einsum('bhrnqk,bhrnke->bhrnqe', p.astype(v.dtype), vb,
                   preferred_element_type=jnp.float32) / den
    lse = (mx + jnp.log(den))[..., 0]
    o = o.reshape(B, H, dilation, lp, hd)[:, :, :, :L].transpose(0, 1, 3, 2, 4).reshape(B, H, S, hd)
    lse = lse.reshape(B, H, dilation, lp)[:, :, :, :L].transpose(0, 1, 3, 2).reshape(B, H, S)
    return o, lse


def dilated_attention(q, k, v):
    outs, lses = zip(*[dilated_branch(q, k, v, w, d) for (w, d) in DILATED_CONFIGS])
    wts = jax.nn.softmax(jnp.stack(lses), axis=0)
    return jnp.sum(jnp.stack(outs) * wts[..., None], axis=0)


def hgrn2_scan(q, k, v, log_f):
    B, S, H, dk = q.shape
    dv = v.shape[-1]
    nc = S // HGRN_CHUNK

    def chunks(t):
        return t.reshape(B, nc, HGRN_CHUNK, H, t.shape[-1]).transpose(1, 0, 3, 2, 4)

    causal = jnp.tril(jnp.ones((HGRN_CHUNK, HGRN_CHUNK), dtype=bool))[:, :, None]

    def step(state, inp):
        qc, kc, vc, ac = inp
        b = jnp.cumsum(ac, axis=2)
        decay = jnp.exp(jnp.where(causal, b[:, :, :, None, :] - b[:, :, None, :, :], -jnp.inf))
        attn = jnp.einsum('bhtd,bhsd,bhtsd->bhts', qc, kc, decay)
        o = (jnp.einsum('bhts,bhse->bhte', attn, vc)
             + jnp.einsum('bhtd,bhde->bhte', qc * jnp.exp(b), state))
        b_last = b[:, :, -1:, :]
        state = (jnp.exp(b_last[:, :, 0, :, None]) * state
                 + jnp.einsum('bhsd,bhse->bhde', kc * jnp.exp(b_last - b), vc))
        return state, o

    state0 = jnp.zeros((B, H, dk, dv), jnp.float32)
    _, o = lax.scan(step, state0, (chunks(q), chunks(k), chunks(v), chunks(log_f)))
    return o.transpose(1, 0, 3, 2, 4).reshape(B, S, H, dv)


def hgrn2_mixer(hq, hf, hi, hg, lb, norm_w):
    B, S, _ = hq.shape
    shp = (B, S, N_HGRN_HEADS, HGRN_EXPAND)
    q = jax.nn.silu(hq.astype(jnp.float32)).reshape(shp)
    fp = hf.astype(jnp.float32).reshape(shp)
    log_f = jnp.logaddexp(jnp.log(lb), jnp.log1p(-lb) + jax.nn.log_sigmoid(fp))
    k = (1 - lb) * jax.nn.sigmoid(-fp)
    v = hi.astype(jnp.float32).reshape(B, S, N_HGRN_HEADS, HGRN_HEAD_DIM)
    o = hgrn2_scan(q, k, v, log_f)
    o = o * lax.rsqrt(jnp.mean(jnp.square(o), axis=-1, keepdims=True) + RMS_EPS)
    o = o * norm_w.reshape(N_HGRN_HEADS, HGRN_HEAD_DIM)
    o = o.reshape(B, S, HGRN_WIDTH) * jax.nn.silu(hg.astype(jnp.float32))
    return o.astype(hq.dtype)


def hybrid_mixer(h, pos, w_in, w_out, norm_w, lb):
    B, S, _ = h.shape
    aq, ak, av, hq, hf, hi, hg = jnp.split(h @ w_in, IN_SPLITS, axis=-1)

    def heads(t):
        return t.reshape(B, S, N_ATTN_HEADS, HEAD_DIM).transpose(0, 2, 1, 3)

    q = partial_rope(heads(aq), pos) * (HEAD_DIM ** -0.5)
    k = partial_rope(heads(ak), pos)
    v = heads(av)
    ao = dilated_attention(q, k, v).astype(h.dtype).transpose(0, 2, 1, 3).reshape(B, S, ATTN_WIDTH)
    go = hgrn2_mixer(hq, hf, hi, hg, lb, norm_w)
    return jnp.concatenate([ao, go], axis=-1) @ w_out


def post_norm_update(x, y, gate, g, b, res_weight):
    return layer_norm(DEEPNORM_ALPHA * x + res_weight * (1 + gate[:, None, :]) * y, g, b)


def setup_inputs(seed: int = 0) -> dict:
    key = jax.random.key(seed)
    ks = jax.random.split(key, 16)
    nrm = jax.random.normal
    x = nrm(ks[0], (BATCH, SEQ, D_MODEL), jnp.float32)
    c = nrm(ks[1], (BATCH, D_MODEL), jnp.float32)
    positions = jnp.broadcast_to(jnp.arange(SEQ, dtype=jnp.int32)[None, :], (BATCH, SEQ))
    ln_g = 1.0 + 0.02 * nrm(ks[2], (DEPTH, N_SUBLAYERS, D_MODEL), jnp.float32)
    ln_b = 0.02 * nrm(ks[3], (DEPTH, N_SUBLAYERS, D_MODEL), jnp.float32)
    ada_w = nrm(ks[4], (DEPTH, D_MODEL, N_SUBLAYERS * 3 * D_MODEL), jnp.float32) * (0.1 * D_MODEL ** -0.5)
    ada_b = 0.02 * nrm(ks[5], (DEPTH, N_SUBLAYERS * 3 * D_MODEL), jnp.float32)
    ffn1_w_in = nrm(ks[6], (DEPTH, D_MODEL, 2 * D_FF), jnp.float32) * D_MODEL ** -0.5
    ffn1_w_out = nrm(ks[7], (DEPTH, D_FF, D_MODEL), jnp.float32) * (D_FF ** -0.5 * DEEPNORM_BETA)
    ffn2_w_in = nrm(ks[8], (DEPTH, D_MODEL, 2 * D_FF), jnp.float32) * D_MODEL ** -0.5
    ffn2_w_out = nrm(ks[9], (DEPTH, D_FF, D_MODEL), jnp.float32) * (D_FF ** -0.5 * DEEPNORM_BETA)
    mix_w_in = nrm(ks[10], (DEPTH, D_MODEL, IN_COLS), jnp.float32) * D_MODEL ** -0.5
    mix_w_out = nrm(ks[11], (DEPTH, D_MODEL, D_MODEL), jnp.float32) * (D_MODEL ** -0.5 * DEEPNORM_BETA)
    hgrn_norm_w = 1.0 + 0.02 * nrm(ks[12], (DEPTH, HGRN_WIDTH), jnp.float32)
    hgrn_lb_logits = 0.5 * nrm(ks[13], (DEPTH, HGRN_WIDTH), jnp.float32)
    return {'x': x, 'c': c, 'positions': positions, 'ln_g': ln_g, 'ln_b': ln_b,
            'ada_w': ada_w, 'ada_b': ada_b,
            'ffn1_w_in': ffn1_w_in, 'ffn1_w_out': ffn1_w_out,
            'ffn2_w_in': ffn2_w_in, 'ffn2_w_out': ffn2_w_out,
            'mix_w_in': mix_w_in, 'mix_w_out': mix_w_out,
            'hgrn_norm_w': hgrn_norm_w, 'hgrn_lb_logits': hgrn_lb_logits}


def reference(x, c, positions, ln_g, ln_b, ada_w, ada_b, ffn1_w_in, ffn1_w_out,
              ffn2_w_in, ffn2_w_out, mix_w_in, mix_w_out, hgrn_norm_w, hgrn_lb_logits):
    B = x.shape[0]
    lb_all = jnp.cumsum(jax.nn.softmax(hgrn_lb_logits.astype(jnp.float32), axis=0), axis=0)
    lb_all = lb_all - lb_all[0:1]
    cond = jax.nn.silu(c)
    for l in range(DEPTH):
        ada = (cond @ ada_w[l] + ada_b[l]).reshape(B, N_SUBLAYERS, 3, D_MODEL)
        h = modulate(x, ada[:, 0, 0], ada[:, 0, 1])
        x = post_norm_update(x, swiglu_ffn(h, ffn1_w_in[l], ffn1_w_out[l]), ada[:, 0, 2],
                             ln_g[l, 0], ln_b[l, 0], FFN_RES_WEIGHT)
        h = modulate(x, ada[:, 1, 0], ada[:, 1, 1])
        lb = lb_all[l].reshape(N_HGRN_HEADS, HGRN_EXPAND)
        y = hybrid_mixer(h, positions, mix_w_in[l], mix_w_out[l], hgrn_norm_w[l], lb)
        x = post_norm_update(x, y, ada[:, 1, 2], ln_g[l, 1], ln_b[l, 1], 1.0)
        h = modulate(x, ada[:, 2, 0], ada[:, 2, 1])
        x = post_norm_update(x, swiglu_ffn(h, ffn2_w_in[l], ffn2_w_out[l]), ada[:, 2, 2],
                             ln_g[l, 2], ln_b[l, 2], FFN_RES_WEIGHT)
    return x
```

```cpp
#include <hip/hip_runtime.h>
#include <hip/hip_cooperative_groups.h>
#include <cstdio>
#include <cstdint>
#include <cmath>
namespace cg = cooperative_groups;
namespace pg8 {
#define PG8_LAS __attribute__((address_space(3)))
typedef unsigned short bf16_t;
typedef short bf16x8 __attribute__((ext_vector_type(8)));
typedef float f32x4 __attribute__((ext_vector_type(4)));
typedef unsigned u32x4 __attribute__((ext_vector_type(4)));
constexpr int BM = 256, BK = 64, HALF = 128, HTB = HALF * BK * 2  , STAGE_BYTES = 8 * HTB, NXCD = 8, WGM = 8;

__host__ __device__ __forceinline__ int lds_byte(int r, int c) { const int st = (r >> 4) * 2 + (c >> 5), rr = r & 15, cc = c & 31, ob = rr * 64 + cc * 2; return st * 1024 + (ob ^ (((ob >> 9) & 1) << 5)); }
__host__ __device__ __forceinline__ void stage_rc(int b, int& R, int& C) { const int st = b / 1024, sb = b % 1024, swz = sb ^ (((sb >> 9) & 1) << 5); R = (st >> 1) * 16 + swz / 64; C = (st & 1) * 32 + (swz % 64) / 2; }
__host__ __device__ __forceinline__ int perm32(int rho) { const int n = rho >> 4, i = rho & 15; return 8 * (i >> 2) + 4 * n + (i & 3); }

struct Unit { int pm, pn; };
struct Gemm { const bf16_t* A; const bf16_t* Bt; int M, N, K; };

struct StaticOrder {
    int nM, nN, nwg, G, c;
    __host__ __device__ void init(int M, int N, int G_, int c_) { nM = M / BM; nN = N / BM; nwg = nM * nN; G = G_; c = c_; }
    __host__ __device__ bool next(int i, Unit& u) const {
        const long L = (long)i * G + c; if (L >= nwg) return false;
        int wgid = (int)L; { const int q = nwg / NXCD, r = nwg % NXCD, xcd = wgid % NXCD, off = wgid / NXCD; wgid = (xcd < r ? xcd * (q + 1) : r * (q + 1) + (xcd - r) * q) + off; }
        const int nig = WGM * nN, gid = wgid / nig, fm = gid * WGM, gsz = (nM - fm) < WGM ? (nM - fm) : WGM;
        u.pm = fm + ((wgid % nig) % gsz); u.pn = (wgid % nig) / gsz; return true;
    }
    __device__ __forceinline__ void a_ready(const Unit&) const {}
    __device__ __forceinline__ void done(const Unit&) const {}
};

typedef float f32x2c __attribute__((ext_vector_type(2))); typedef __bf16 bf16x2c __attribute__((ext_vector_type(2)));
__device__ __forceinline__ unsigned cvt_pk_bf16(float lo, float hi) { const f32x2c v = {lo, hi}; const bf16x2c b = __builtin_convertvector(v, bf16x2c); return __builtin_bit_cast(unsigned, b); }
typedef float f32x2 __attribute__((ext_vector_type(2)));
#define PG8_GAS __attribute__((address_space(1)))
typedef _Float16 f16x2_t __attribute__((ext_vector_type(2)));
__device__ __forceinline__ unsigned cvt_pk_f16(float lo, float hi) { f16x2_t v = {(_Float16)lo, (_Float16)hi}; return __builtin_bit_cast(unsigned, v); }
__device__ __forceinline__ float silu_f(float v) { return v * __builtin_amdgcn_rcpf(1.f + __expf(-v)); }

struct EpiSwiglu {
    static constexpr bool PERM = true, AFTER_DRAIN = false;
    bf16_t* O; int ldc;
    __device__ __forceinline__ void operator()(const f32x4 (&acc)[2][2][4][2], const Unit& u, int wr, int wc, int fr, int fq) const {
        const int row0 = u.pm * BM + wr * 64 + fr; const int col0 = u.pn * HALF + wc * 32 + 8 * fq;
#pragma unroll
        for (int ai = 0; ai < 2; ++ai)
#pragma unroll
            for (int m = 0; m < 4; ++m) {
                bf16_t* rowp = O + (size_t)(row0 + ai * HALF + m * 16) * ldc + col0;
                const f32x4 g0 = acc[ai][0][m][0], g1 = acc[ai][0][m][1], u0 = acc[ai][1][m][0], u1 = acc[ai][1][m][1];
                u32x4 w;
                w.x = cvt_pk_bf16(silu_f(g0[0]) * u0[0], silu_f(g0[1]) * u0[1]); w.y = cvt_pk_bf16(silu_f(g0[2]) * u0[2], silu_f(g0[3]) * u0[3]);
                w.z = cvt_pk_bf16(silu_f(g1[0]) * u1[0], silu_f(g1[1]) * u1[1]); w.w = cvt_pk_bf16(silu_f(g1[2]) * u1[2], silu_f(g1[3]) * u1[3]);
                *(PG8_GAS u32x4*)rowp = w;
            }
    }
};

struct EpiResid {
    static constexpr bool PERM = false, AFTER_DRAIN = false;
    const float* xin; float* Z; const float* stats; const float* lng; const float* lnb; const float* gate; float alpha, resw; int mode; unsigned scr;
    __device__ __forceinline__ void operator()(const f32x4 (&acc)[2][2][4][2], const Unit& u, int wr, int wc, int fr, int fq) const {
        const int b = u.pm >> 5, lane = fr + 16 * fq;
        PG8_LAS unsigned char* sw = (PG8_LAS unsigned char*)(size_t)(scr + (unsigned)(wr * 4 + wc) * 2048u);
        const int wrow = fr * 128, rrow = lane >> 3, rch = lane & 7;
        f32x4 gt[2], lg[2], lb[2];
#pragma unroll
        for (int bj = 0; bj < 2; ++bj) {
            const int c = u.pn * BM + bj * HALF + wc * 32 + 4 * rch;
            gt[bj] = (*(const PG8_GAS f32x4*)(gate + (size_t)b * 9216 + c) + 1.f) * resw;
            lg[bj] = (f32x4){1.f, 1.f, 1.f, 1.f}; lb[bj] = (f32x4){0.f, 0.f, 0.f, 0.f};
            if (mode) { lg[bj] = *(const PG8_GAS f32x4*)(lng + c); lb[bj] = *(const PG8_GAS f32x4*)(lnb + c); }
        }
#pragma unroll
        for (int ai = 0; ai < 2; ++ai)
#pragma unroll
            for (int m = 0; m < 4; ++m) {
                const int r0 = u.pm * BM + ai * HALF + wr * 64 + m * 16;
                f32x2 st2[2];
#pragma unroll
                for (int s = 0; s < 2; ++s) { st2[s] = (f32x2){0.f, 1.f}; if (mode) st2[s] = *(const PG8_GAS f32x2*)(stats + 2 * (size_t)(r0 + 8 * s + rrow)); }
#pragma unroll
                for (int bj = 0; bj < 2; ++bj) {
                    const size_t off0 = (size_t)(r0 + rrow) * 1024 + u.pn * BM + bj * HALF + wc * 32 + 4 * rch;
                    f32x4 xo[2];
#pragma unroll
                    for (int s = 0; s < 2; ++s) xo[s] = mode ? *(const PG8_GAS f32x4*)(Z + off0 + (size_t)s * 8192) : *(const PG8_GAS f32x4*)(xin + off0 + (size_t)s * 8192);
#pragma unroll
                    for (int n = 0; n < 2; ++n) *(PG8_LAS f32x4*)(sw + wrow + (((4 * n + fq) ^ (fr & 7)) << 4)) = acc[ai][bj][m][n];
                    asm volatile("s_waitcnt lgkmcnt(0)" ::: "memory");
                    f32x4 av[2];
#pragma unroll
                    for (int s = 0; s < 2; ++s) av[s] = *(const PG8_LAS f32x4*)(sw + (8 * s + rrow) * 128 + ((rch ^ ((8 * s + rrow) & 7)) << 4));
                    asm volatile("s_waitcnt lgkmcnt(0)" ::: "memory");
#pragma unroll
                    for (int s = 0; s < 2; ++s) {
                        f32x4 xv = xo[s];
                        if (mode) xv = (xv - st2[s].x) * st2[s].y * lg[bj] + lb[bj];
                        *(PG8_GAS f32x4*)(Z + off0 + (size_t)s * 8192) = xv * alpha + gt[bj] * av[s];
                    }
                }
            }
    }
};

__device__ __forceinline__ float gate_logf(float fp, float lb) {
    const float e = __expf(-fabsf(fp)), l1pe = __logf(1.f + e);
    return (fp >= 0.f ? __logf(1.f + lb * e) : (lb > 0.f ? __logf(lb + e) : fp)) - l1pe;
}
struct EpiMixIn {
    static constexpr bool PERM = true, AFTER_DRAIN = false;
    bf16_t* proj; const float* rope; const float* lbl;
    __device__ __forceinline__ void operator()(const f32x4 (&acc)[2][2][4][2], const Unit& u, int wr, int wc, int fr, int fq) const {
        const int seg = u.pn >> 1; const int rbase = u.pm * BM + wr * 64 + fr; const int b = u.pm >> 5;
        bf16_t* segp = proj + (size_t)seg * ((size_t)65536 * 512);
#pragma unroll
        for (int bj = 0; bj < 2; ++bj) {
            const int wcol = (u.pn & 1) * 256 + bj * HALF + wc * 32 + 8 * fq;
            if (seg < 3) {
                const int head = wcol >> 6, ch = wcol & 63;
                const bool rotw = (seg < 2) && ((wc & 1) == 0);
#pragma unroll
                for (int ai = 0; ai < 2; ++ai)
#pragma unroll
                    for (int m = 0; m < 4; ++m) {
                        const int r = rbase + ai * HALF + m * 16; const int s = r & 8191;
                        f32x4 v0 = acc[ai][bj][m][0], v1 = acc[ai][bj][m][1];
                        if (rotw) {
                            f32x4 p0, p1;
#pragma unroll
                            for (int j = 0; j < 4; ++j) { p0[j] = __shfl_xor(v0[j], 16); p1[j] = __shfl_xor(v1[j], 16); }
                            if (fq < 2) {
                                const f32x4 c0 = *(const PG8_GAS f32x4*)(rope + (size_t)r * 16), c1 = *(const PG8_GAS f32x4*)(rope + (size_t)r * 16 + 4);
                                const f32x4 s0 = *(const PG8_GAS f32x4*)(rope + (size_t)r * 16 + 8), s1 = *(const PG8_GAS f32x4*)(rope + (size_t)r * 16 + 12);
                                if (fq == 0) { v0 = v0 * c0 - p0 * s0; v1 = v1 * c1 - p1 * s1; }
                                else { v0 = v0 * c0 + p0 * s0; v1 = v1 * c1 + p1 * s1; }
                            }
                        }
                        if (seg == 0) { v0 = v0 * 0.18033688011112042f; v1 = v1 * 0.18033688011112042f; }
                        u32x4 w; w.x = cvt_pk_bf16(v0[0], v0[1]); w.y = cvt_pk_bf16(v0[2], v0[3]); w.z = cvt_pk_bf16(v1[0], v1[1]); w.w = cvt_pk_bf16(v1[2], v1[3]);
                        *(PG8_GAS u32x4*)(segp + ((size_t)((b * 8 + head) * 8192 + s)) * 64 + ch) = w;
                    }
            } else {
#pragma unroll
                for (int ai = 0; ai < 2; ++ai)
#pragma unroll
                    for (int m = 0; m < 4; ++m) {
                        const int r = rbase + ai * HALF + m * 16;
                        f32x4 v0 = acc[ai][bj][m][0], v1 = acc[ai][bj][m][1];
                        if (seg == 3 || seg == 6) {
#pragma unroll
                            for (int j = 0; j < 4; ++j) { v0[j] = silu_f(v0[j]); v1[j] = silu_f(v1[j]); }
                        }
                        if (seg == 4) {
                            const f32x4 l0 = *(const PG8_GAS f32x4*)(lbl + wcol), l1 = *(const PG8_GAS f32x4*)(lbl + wcol + 4);
#pragma unroll
                            for (int j = 0; j < 4; ++j) { v0[j] = gate_logf(v0[j], l0[j]); v1[j] = gate_logf(v1[j], l1[j]); }
                        }
                        u32x4 w;
                        if (seg == 4) { w.x = cvt_pk_f16(v0[0], v0[1]); w.y = cvt_pk_f16(v0[2], v0[3]); w.z = cvt_pk_f16(v1[0], v1[1]); w.w = cvt_pk_f16(v1[2], v1[3]); }
                        else { w.x = cvt_pk_bf16(v0[0], v0[1]); w.y = cvt_pk_bf16(v0[2], v0[3]); w.z = cvt_pk_bf16(v1[0], v1[1]); w.w = cvt_pk_bf16(v1[2], v1[3]); }
                        *(PG8_GAS u32x4*)(segp + (size_t)r * 512 + wcol) = w;
                    }
            }
        }
    }
};

template <class Epi, class Sched, bool ALIGN_EPI = false, bool SP2 = false>
__device__ __forceinline__ void gemm_phase(PG8_LAS unsigned char* lds, const Gemm g, const Sched& S, const Epi& E, const int tid) {
    const int wid = __builtin_amdgcn_readfirstlane(tid >> 6), lane = tid & 63, wr = wid >> 2, wc = wid & 3, fr = lane & 15, fq = lane >> 4;
    const int K = g.K, nt = K / BK;
    unsigned voffA[2], voffB[2];
#pragma unroll
    for (int i = 0; i < 2; ++i) { int R, C; stage_rc(tid * 16 + i * 8192, R, C); const int Rb = Epi::PERM ? ((R & ~31) + perm32(R & 31)) : R;
        voffA[i] = (unsigned)(R * K + C) * 2u; voffB[i] = (unsigned)(Rb * K + C) * 2u; }
    const size_t kstep = (size_t)(BK * 2);
    const size_t hstep = (size_t)HALF * K * 2;
    const size_t tstep = 2 * hstep;
    const unsigned ldsw = (unsigned)wid * 1024u;
    const int aoff = lds_byte(wr * 64 + fr, fq * 8), boff = lds_byte(wc * 32 + fr, fq * 8);
#define PG8_SA(b, h) (((b) * 2 + (h)) * HTB)
#define PG8_SB(b, h) ((4 + (b) * 2 + (h)) * HTB)
#define PG8_STAGE(bufoff, gbase, voff) do { _Pragma("unroll") for (int _i = 0; _i < 2; ++_i) \
        __builtin_amdgcn_global_load_lds((const unsigned*)((const char*)(gbase) + (voff)[_i]), (PG8_LAS unsigned*)(lds + (bufoff) + ldsw + _i * 8192), 16, 0, 0); } while (0)
#define PG8_LDA(dst, b, h) do { _Pragma("unroll") for (int m = 0; m < 4; ++m) _Pragma("unroll") for (int k = 0; k < 2; ++k) dst[m][k] = *(const PG8_LAS bf16x8*)(lds + PG8_SA(b, h) + aoff + m * 2048 + k * 1024); } while (0)
#define PG8_LDB(dst, b, h) do { _Pragma("unroll") for (int n = 0; n < 2; ++n) _Pragma("unroll") for (int k = 0; k < 2; ++k) dst[n][k] = *(const PG8_LAS bf16x8*)(lds + PG8_SB(b, h) + boff + n * 2048 + k * 1024); } while (0)
#define PG8_MMA(ai, bj, At, Bt) do { __builtin_amdgcn_s_setprio(1); _Pragma("unroll") for (int m = 0; m < 4; ++m) _Pragma("unroll") for (int n = 0; n < 2; ++n) _Pragma("unroll") for (int k = 0; k < 2; ++k) \
        acc[ai][bj][m][n] = __builtin_amdgcn_mfma_f32_16x16x32_bf16(Bt[n][k], At[m][k], acc[ai][bj][m][n], 0, 0, 0); __builtin_amdgcn_s_setprio(0); } while (0)
#define PG8_WAIT_V(n) asm volatile("s_waitcnt vmcnt(" #n ")" ::: "memory")
#define PG8_WAIT_L(n) asm volatile("s_waitcnt lgkmcnt(" #n ")" ::: "memory")
#define PG8_BAR __builtin_amdgcn_s_barrier()
#define PG8_SCHED __builtin_amdgcn_sched_barrier(0)
    Unit cur, nxt; int ui = 0;
    if (!S.next(0, cur)) return;
    f32x4 acc[2][2][4][2];
#pragma unroll
    for (int a = 0; a < 2; ++a)
#pragma unroll
        for (int b = 0; b < 2; ++b)
#pragma unroll
            for (int m = 0; m < 4; ++m)
#pragma unroll
                for (int n = 0; n < 2; ++n) acc[a][b][m][n] = (f32x4){0.f, 0.f, 0.f, 0.f};
    bf16x8 At[4][2], B0[2][2], B1[2][2];
    const char* cA = (const char*)g.A + (size_t)cur.pm * tstep; const char* cB = (const char*)g.Bt + (size_t)cur.pn * tstep;
    S.a_ready(cur);
    if constexpr (SP2) {
        PG8_STAGE(PG8_SB(0, 0), cB, voffB); PG8_STAGE(PG8_SB(0, 1), cB + hstep, voffB); PG8_STAGE(PG8_SA(0, 0), cA, voffA); PG8_STAGE(PG8_SA(0, 1), cA + hstep, voffA);
        if (wr == 1) PG8_BAR;
        PG8_WAIT_V(2); PG8_BAR;
        PG8_STAGE(PG8_SB(1, 0), cB + kstep, voffB); PG8_STAGE(PG8_SA(1, 0), cA + kstep, voffA); PG8_STAGE(PG8_SB(1, 1), cB + hstep + kstep, voffB);
        PG8_WAIT_V(6); PG8_BAR;
    } else {
        PG8_STAGE(PG8_SB(0, 0), cB, voffB); PG8_STAGE(PG8_SA(0, 0), cA, voffA); PG8_STAGE(PG8_SB(0, 1), cB + hstep, voffB); PG8_STAGE(PG8_SA(0, 1), cA + hstep, voffA);
        if (wr == 1) PG8_BAR;
        PG8_WAIT_V(4); PG8_BAR;
        PG8_STAGE(PG8_SB(1, 0), cB + kstep, voffB); PG8_STAGE(PG8_SA(1, 0), cA + kstep, voffA); PG8_STAGE(PG8_SB(1, 1), cB + hstep + kstep, voffB);
        PG8_WAIT_V(6); PG8_BAR;
    }
    for (;;) {
        const bool has_next = S.next(ui + 1, nxt);
        const char* nA = has_next ? (const char*)g.A + (size_t)nxt.pm * tstep : cA; const char* nB = has_next ? (const char*)g.Bt + (size_t)nxt.pn * tstep : cB;
        for (int t = 0; t < nt; t += 2) {
            const bool last = (t == nt - 2);
            const char* a1 = cA + (size_t)(t + 1) * kstep;
            const char* a2 = last ? nA : cA + (size_t)(t + 2) * kstep; const char* b2 = last ? nB : cB + (size_t)(t + 2) * kstep;
            const char* a3 = a2 + kstep; const char* b3 = b2 + kstep;
            if (last && has_next) S.a_ready(nxt);
            if constexpr (SP2) {
            PG8_LDB(B0, 0, 0); PG8_LDB(B1, 0, 1); PG8_SCHED; PG8_LDA(At, 0, 0); PG8_STAGE(PG8_SA(1, 1), a1 + hstep, voffA);
            PG8_WAIT_V(8); PG8_WAIT_L(0); PG8_BAR; PG8_MMA(0, 0, At, B0); PG8_MMA(0, 1, At, B1); PG8_BAR; PG8_SCHED;
            PG8_LDA(At, 0, 1); PG8_STAGE(PG8_SB(0, 0), b2, voffB); PG8_STAGE(PG8_SB(0, 1), b2 + hstep, voffB); PG8_STAGE(PG8_SA(0, 0), a2, voffA);
            PG8_WAIT_V(8); PG8_WAIT_L(0); PG8_BAR; PG8_MMA(1, 0, At, B0); PG8_MMA(1, 1, At, B1); PG8_BAR; PG8_SCHED;
            PG8_LDB(B0, 1, 0); PG8_LDB(B1, 1, 1); PG8_SCHED; PG8_LDA(At, 1, 0); PG8_STAGE(PG8_SA(0, 1), a2 + hstep, voffA);
            PG8_WAIT_V(8); PG8_WAIT_L(0); PG8_BAR; PG8_MMA(0, 0, At, B0); PG8_MMA(0, 1, At, B1); PG8_BAR; PG8_SCHED;
            PG8_LDA(At, 1, 1); PG8_STAGE(PG8_SB(1, 0), b3, voffB); PG8_STAGE(PG8_SB(1, 1), b3 + hstep, voffB); PG8_STAGE(PG8_SA(1, 0), a3, voffA);
            PG8_WAIT_V(8); PG8_WAIT_L(0); PG8_BAR; PG8_MMA(1, 0, At, B0); PG8_MMA(1, 1, At, B1); PG8_BAR; PG8_SCHED;
            } else {
            PG8_LDB(B0, 0, 0); PG8_SCHED; PG8_LDA(At, 0, 0); PG8_STAGE(PG8_SA(1, 1), a1 + hstep, voffA);
            PG8_WAIT_L(8); PG8_BAR; PG8_WAIT_L(0); PG8_MMA(0, 0, At, B0); PG8_BAR; PG8_SCHED;
            PG8_LDB(B1, 0, 1); PG8_STAGE(PG8_SB(0, 0), b2, voffB);
            PG8_BAR; PG8_WAIT_L(0); PG8_MMA(0, 1, At, B1); PG8_BAR;
            PG8_LDA(At, 0, 1); PG8_STAGE(PG8_SA(0, 0), a2, voffA);
            PG8_BAR; PG8_WAIT_L(0); PG8_MMA(1, 0, At, B0); PG8_BAR; PG8_SCHED;
            PG8_STAGE(PG8_SB(0, 1), b2 + hstep, voffB);
            PG8_WAIT_V(6); PG8_BAR; PG8_MMA(1, 1, At, B1); PG8_BAR;
            PG8_LDB(B0, 1, 0); PG8_SCHED; PG8_LDA(At, 1, 0); PG8_STAGE(PG8_SA(0, 1), a2 + hstep, voffA);
            PG8_WAIT_L(8); PG8_BAR; PG8_WAIT_L(0); PG8_MMA(0, 0, At, B0); PG8_BAR; PG8_SCHED;
            PG8_LDB(B1, 1, 1); PG8_STAGE(PG8_SB(1, 0), b3, voffB);
            PG8_BAR; PG8_WAIT_L(0); PG8_MMA(0, 1, At, B1); PG8_BAR;
            PG8_LDA(At, 1, 1); PG8_STAGE(PG8_SA(1, 0), a3, voffA);
            PG8_BAR; PG8_WAIT_L(0); PG8_MMA(1, 0, At, B0); PG8_BAR; PG8_SCHED;
            PG8_STAGE(PG8_SB(1, 1), b3 + hstep, voffB);
            PG8_WAIT_V(6); PG8_BAR; PG8_MMA(1, 1, At, B1); PG8_BAR;
            }
        }
        if constexpr (ALIGN_EPI) { if (wr == 0) PG8_BAR; }
        if constexpr (!Epi::AFTER_DRAIN) { E(acc, cur, wr, wc, fr, fq); S.done(cur); }
        if (!has_next) break;
#pragma unroll
        for (int a = 0; a < 2; ++a)
#pragma unroll
            for (int b = 0; b < 2; ++b)
#pragma unroll
                for (int m = 0; m < 4; ++m)
#pragma unroll
                    for (int n = 0; n < 2; ++n) acc[a][b][m][n] = (f32x4){0.f, 0.f, 0.f, 0.f};
        cur = nxt; cA = nA; cB = nB; ++ui;
        if constexpr (ALIGN_EPI) { if (wr == 1) PG8_BAR; }
    }
    PG8_WAIT_V(0);
    if constexpr (!ALIGN_EPI) { if (wr == 0) PG8_BAR; }
    PG8_BAR;
    if constexpr (Epi::AFTER_DRAIN) { E.fused(acc, cur, wr, wc, fr, fq, lds, wid, lane); S.done(cur); }
#undef PG8_SA
#undef PG8_SB
#undef PG8_STAGE
#undef PG8_LDA
#undef PG8_LDB
#undef PG8_MMA
#undef PG8_WAIT_V
#undef PG8_WAIT_L
#undef PG8_BAR
#undef PG8_SCHED
}
}

#define LAS __attribute__((address_space(3)))
typedef unsigned short bf16;
typedef unsigned v4u __attribute__((ext_vector_type(4)));
typedef unsigned v2u __attribute__((ext_vector_type(2)));
typedef float f32x4 __attribute__((ext_vector_type(4)));
typedef float f32x2v __attribute__((ext_vector_type(2)));
typedef float f32x16 __attribute__((ext_vector_type(16)));
typedef short bf16x8 __attribute__((ext_vector_type(8)));
typedef short s16x4 __attribute__((ext_vector_type(4)));
typedef short v4i16_t __attribute__((ext_vector_type(4)));

constexpr int NB = 8, SEQ = 8192, M = NB * SEQ, D = 1024, FF = 2816, NIN = 3584, NADA = 9216;
constexpr float LN_EPS = 1e-5f, RMS_EPS = 1e-6f, DN_ALPHA = 1.41421356237309515f;
constexpr size_t MiB = 1u << 20;
constexpr size_t WS_ADA = 0, WS_STATS = 1 * MiB, WS_LB = 1 * MiB + 512 * 1024, WS_ROPE = 2 * MiB, WS_HDEC = 6 * MiB, WS_ML = 8 * MiB;
constexpr size_t WS_W = 16 * MiB;
constexpr size_t W_LAYER = 42 * MiB, W_1IN = 0, W_1OUT = 11 * MiB, W_2IN = 11 * MiB + 5632 * 1024, W_2OUT = 22 * MiB + 5632 * 1024, W_MIN = 33 * MiB, W_MOUT = 40 * MiB;
constexpr size_t WS_H = 112 * MiB;
constexpr size_t WS_BIG = 240 * MiB;
constexpr size_t WS_DS = 688 * MiB;
constexpr size_t WS_OP = 816 * MiB;
constexpr size_t WS_END = 944 * MiB;
constexpr size_t SEG = (size_t)65536 * 512;
constexpr int LDS_BYTES = 163840;

__device__ __forceinline__ unsigned f2bf(float f) { unsigned u = __builtin_bit_cast(unsigned, f); return (u + 0x7fffu + ((u >> 16) & 1u)) >> 16; }
__device__ __forceinline__ unsigned pk2(float lo, float hi) { return pg8::cvt_pk_bf16(lo, hi); }
__device__ __forceinline__ float bf2f(unsigned short v) { return __builtin_bit_cast(float, (unsigned)v << 16); }
__device__ __forceinline__ float h2f(unsigned short v) { return (float)__builtin_bit_cast(_Float16, v); }
__device__ __forceinline__ float wave_sum(float v) {
#pragma unroll
    for (int o = 1; o < 64; o <<= 1) v += __shfl_xor(v, o);
    return v;
}
#define LDS_WAIT() asm volatile("s_waitcnt lgkmcnt(0)" ::: "memory")
#define GAS __attribute__((address_space(1)))
template <class T> __device__ __forceinline__ T gld(const void* p) { return *(const GAS T*)p; }
template <class T> __device__ __forceinline__ void gst(void* p, T v) { *(GAS T*)p = v; }

struct Args { const void* in[15]; float* out; unsigned char* ws; float invf[8]; int ph_lo, ph_hi; };

__device__ __forceinline__ void transpose_item(const float* W, int K, int N, bf16* WT, LAS float* scr, int item, int lane, bool swiglu) {
    const int nblk = N / 32, kb = item / nblk, nb = item % nblk, k0 = 64 * kb, n0 = 32 * nb;
    int sc0 = n0;
    if (swiglu) { const int pn = n0 >> 8, w = n0 & 255; sc0 = (w >> 7) * FF + pn * 128 + (w & 127); }
#pragma unroll 8
    for (int i = 0; i < 32; ++i) { const int kk = 2 * i + (lane >> 5); scr[kk * 33 + (lane & 31)] = W[(size_t)(k0 + kk) * N + sc0 + (lane & 31)]; }
    LDS_WAIT();
    const int c = lane & 7;
#pragma unroll
    for (int j = 0; j < 4; ++j) { const int n = (lane >> 3) + 8 * j; const LAS float* s = scr + (8 * c) * 33 + n;
        v4u o; o.x = pk2(s[0 * 33], s[1 * 33]); o.y = pk2(s[2 * 33], s[3 * 33]); o.z = pk2(s[4 * 33], s[5 * 33]); o.w = pk2(s[6 * 33], s[7 * 33]);
        *(v4u*)(WT + (size_t)(n0 + n) * K + k0 + 8 * c) = o; }
    LDS_WAIT();
}

__device__ __forceinline__ void prologue_phase(const Args& a, LAS unsigned char* lds, int tid, int lane, int wave, int G) {
    unsigned char* ws = a.ws;
    const int gw = blockIdx.x * 8 + wave, NGW = G * 8;
    {
        LAS float* scr = (LAS float*)(lds + wave * 16384);
        constexpr int I_FI = 16 * 176, I_FO = 44 * 32, I_MI = 16 * 112, I_MO = 16 * 32, I_L = 2 * I_FI + 2 * I_FO + I_MI + I_MO;
        for (int it = gw; it < 2 * I_L; it += NGW) {
            const int l = it / I_L; int r = it % I_L;
            unsigned char* wl = ws + WS_W + (size_t)l * W_LAYER;
            if (r < I_FI) { transpose_item((const float*)a.in[7] + (size_t)l * D * 2 * FF, D, 2 * FF, (bf16*)(wl + W_1IN), scr, r, lane, true); continue; } r -= I_FI;
            if (r < I_FI) { transpose_item((const float*)a.in[9] + (size_t)l * D * 2 * FF, D, 2 * FF, (bf16*)(wl + W_2IN), scr, r, lane, true); continue; } r -= I_FI;
            if (r < I_FO) { transpose_item((const float*)a.in[8] + (size_t)l * FF * D, FF, D, (bf16*)(wl + W_1OUT), scr, r, lane, false); continue; } r -= I_FO;
            if (r < I_FO) { transpose_item((const float*)a.in[10] + (size_t)l * FF * D, FF, D, (bf16*)(wl + W_2OUT), scr, r, lane, false); continue; } r -= I_FO;
            if (r < I_MI) { transpose_item((const float*)a.in[11] + (size_t)l * D * NIN, D, NIN, (bf16*)(wl + W_MIN), scr, r, lane, false); continue; } r -= I_MI;
            transpose_item((const float*)a.in[12] + (size_t)l * D * D, D, D, (bf16*)(wl + W_MOUT), scr, r, lane, false);
        }
    }
    __syncthreads();
    {
        const float* cin = (const float*)a.in[1]; const float* aw = (const float*)a.in[5]; const float* ab = (const float*)a.in[6];
        float* ada = (float*)(ws + WS_ADA);
        LAS float* red = (LAS float*)lds;
        for (int it = blockIdx.x; it < 512; it += G) {
            const int l = it >> 8, n0 = (it & 255) * 36;
            float acc[8];
#pragma unroll
            for (int b = 0; b < 8; ++b) acc[b] = 0.f;
            if (lane < 36) {
                const float* wp = aw + ((size_t)l * D + wave * 128) * NADA + n0 + lane;
#pragma unroll 8
                for (int k = 0; k < 128; ++k) {
                    const float w = wp[(size_t)k * NADA];
#pragma unroll
                    for (int b = 0; b < 8; ++b) { const float cv = cin[b * D + wave * 128 + k]; acc[b] += cv * __builtin_amdgcn_rcpf(1.f + __expf(-cv)) * w; }
                }
#pragma unroll
                for (int b = 0; b < 8; ++b) red[(wave * 8 + b) * 36 + lane] = acc[b];
            }
            __syncthreads();
            if (tid < 288) { const int b = tid / 36, n = tid % 36; float s = ab[l * NADA + n0 + n];
#pragma unroll
                for (int w = 0; w < 8; ++w) s += red[(w * 8 + b) * 36 + n];
                ada[((size_t)l * 8 + b) * NADA + n0 + n] = s; }
            __syncthreads();
        }
    }
    {
        const float* lg = (const float*)a.in[14]; float* lbv = (float*)(ws + WS_LB);
        const int gt = blockIdx.x * 512 + tid;
        if (gt < 9) ((unsigned*)(ws + WS_LB + 8192))[64 * gt] = 0u;
        if (gt < 512) { const float l0 = lg[gt], l1 = lg[512 + gt]; lbv[gt] = 0.f; lbv[512 + gt] = 1.f / (1.f + __expf(l0 - l1)); }
    }
    {
        const int* pos = (const int*)a.in[2]; float* rope = (float*)(ws + WS_ROPE);
        for (int r = blockIdx.x * 512 + tid; r < M; r += G * 512) {
            const float pf = (float)pos[r];
            f32x4 cv[2], sv[2];
#pragma unroll
            for (int j = 0; j < 8; ++j) {
                const float ang = pf * a.invf[j];
                const double rev = (double)ang * 0.15915494309189535; const float fr = (float)(rev - floor(rev));
                cv[j >> 2][j & 3] = __builtin_amdgcn_cosf(fr); sv[j >> 2][j & 3] = __builtin_amdgcn_sinf(fr);
            }
            *(f32x4*)(rope + (size_t)r * 16) = cv[0]; *(f32x4*)(rope + (size_t)r * 16 + 4) = cv[1];
            *(f32x4*)(rope + (size_t)r * 16 + 8) = sv[0]; *(f32x4*)(rope + (size_t)r * 16 + 12) = sv[1];
        }
    }
}

template <int MODE>
__device__ __forceinline__ void lnmod_phase(const float* src, float* dst, float* stats, bf16* H, const float* lng, const float* lnb, const float* ada_mod  , int lane, int wave, int G) {
    const int gw = blockIdx.x * 8 + wave, NGW = G * 8;
    for (int chunk = gw; chunk < M / 32; chunk += NGW) {
        const int b = chunk >> 8;
        f32x4 g[4], bb[4], sc[4], sh[4];
#pragma unroll
        for (int j = 0; j < 4; ++j) {
            const int c = 4 * lane + 256 * j;
            if (MODE != 0) { g[j] = gld<f32x4>(lng + c); bb[j] = gld<f32x4>(lnb + c); }
            if (MODE != 2) { sh[j] = gld<f32x4>(ada_mod + (size_t)b * NADA + c); sc[j] = gld<f32x4>(ada_mod + (size_t)b * NADA + 1024 + c) + 1.f; }
        }
        f32x4 v[4], nx[4];
        const float* rp = src + (size_t)chunk * 32 * D + 4 * lane;
#pragma unroll
        for (int j = 0; j < 4; ++j) nx[j] = gld<f32x4>(rp + 256 * j);
        for (int i = 0; i < 32; ++i) {
            const int r = chunk * 32 + i;
#pragma unroll
            for (int j = 0; j < 4; ++j) v[j] = nx[j];
            if (i + 1 < 32) {
#pragma unroll
                for (int j = 0; j < 4; ++j) nx[j] = gld<f32x4>(rp + (size_t)(i + 1) * D + 256 * j);
            }
            if (MODE != 0) {
                float s = 0.f;
#pragma unroll
                for (int j = 0; j < 4; ++j) s += (v[j].x + v[j].y) + (v[j].z + v[j].w);
                const float mean = wave_sum(s) * (1.f / D); float s2 = 0.f;
#pragma unroll
                for (int j = 0; j < 4; ++j) { v[j] = v[j] - mean; s2 += (v[j].x * v[j].x + v[j].y * v[j].y) + (v[j].z * v[j].z + v[j].w * v[j].w); }
                const float rstd = 1.f / sqrtf(wave_sum(s2) * (1.f / D) + LN_EPS);
                if (MODE == 1 && lane == 0) gst<f32x2v>(stats + 2 * (size_t)r, (f32x2v){mean, rstd});
#pragma unroll
                for (int j = 0; j < 4; ++j) v[j] = v[j] * rstd * g[j] + bb[j];
            }
            if (MODE == 2) {
#pragma unroll
                for (int j = 0; j < 4; ++j) gst<f32x4>(dst + (size_t)r * D + 4 * lane + 256 * j, v[j]);
            } else {
#pragma unroll
                for (int j = 0; j < 4; ++j) { const f32x4 hv = v[j] * sc[j] + sh[j]; v2u o; o.x = pk2(hv.x, hv.y); o.y = pk2(hv.z, hv.w);
                    gst<v2u>(H + (size_t)r * D + 4 * lane + 256 * j, o); }
            }
        }
    }
}

__device__ __forceinline__ int crow16(int i, int h) { return (i & 3) + 8 * (i >> 2) + 4 * h; }
__device__ __forceinline__ s16x4 vtr(LAS const unsigned char* p) { return __builtin_bit_cast(s16x4, __builtin_amdgcn_ds_read_tr16_b64_v4i16((LAS v4i16_t*)p)); }
constexpr int VP = 128;

struct AttJob { int pos0, d, brmode, bar_after, b, head; size_t hb; };
__device__ __forceinline__ bool att_params(int q, int nun, int G, int wave, AttJob& P) {
    const int ui = q / 6, r = q - 6 * ui, br = r >> 1, jj = r & 1;
    if (ui >= nun) return false;
    int uid;
    if (G == 256) { const int x = blockIdx.x & 7, sl = blockIdx.x >> 3; uid = ((x * 8 + (sl >> 2)) << 3) + (sl & 3) * 2 + ui; }
    else { uid = blockIdx.x + ui * G; if (uid >= 512) return false; }
    const int bh = uid >> 3, T0 = (uid & 7) * 1024;
    const int d = br == 0 ? 16 : (br == 1 ? 4 : 1), pj = wave + 8 * jj;
    const int p0 = d == 1 ? 64 * pj : (d == 4 ? 256 * (pj & 3) + (pj >> 2) : pj);
    P.pos0 = T0 + p0; P.d = d; P.brmode = br; P.bar_after = (jj == 1 && br < 2) ? 1 : 0; P.b = bh >> 3; P.head = bh & 7; P.hb = (size_t)bh * SEQ;
    return true;
}
__device__ __forceinline__ void att_block(const bf16x8 (&kf)[4], const bf16x8 (&qf)[4], const bf16x8 (&va)[4], f32x16& o0, f32x16& o1, float& mrun, float& lrun, bool domask, int lo_, int hi_) {
    f32x16 st;
#pragma unroll
    for (int i = 0; i < 16; ++i) st[i] = 0.f;
#pragma unroll
    for (int kk = 0; kk < 4; ++kk) st = __builtin_amdgcn_mfma_f32_32x32x16_bf16(kf[kk], qf[kk], st, 0, 0, 0);
    if (domask) {
        asm volatile("" : "+v"(lo_), "+v"(hi_));
#pragma unroll
        for (int i = 0; i < 16; ++i) { const int ci = (i & 3) + 8 * (i >> 2); st[i] = ((ci - lo_) | (hi_ - ci)) < 0 ? -INFINITY : st[i]; }
    }
    float bmax = -INFINITY;
#pragma unroll
    for (int i = 0; i < 16; ++i) bmax = fmaxf(bmax, st[i]);
    bmax = fmaxf(bmax, __shfl_xor(bmax, 32));
    const float mnew = fmaxf(mrun, bmax);
    float lsum = 0.f;
#pragma unroll
    for (int i = 0; i < 16; ++i) { st[i] = __builtin_amdgcn_exp2f(st[i] - mnew); lsum += st[i]; }
    lsum += __shfl_xor(lsum, 32);
    const float alpha = __builtin_amdgcn_exp2f(mrun - mnew);
    lrun = lrun * alpha + lsum; mrun = mnew;
#pragma unroll
    for (int i = 0; i < 16; ++i) { o0[i] *= alpha; o1[i] *= alpha; }
#pragma unroll
    for (int s = 0; s < 2; ++s) { v4u w; w.x = pk2(st[8 * s], st[8 * s + 1]); w.y = pk2(st[8 * s + 2], st[8 * s + 3]); w.z = pk2(st[8 * s + 4], st[8 * s + 5]); w.w = pk2(st[8 * s + 6], st[8 * s + 7]);
        const bf16x8 pb = __builtin_bit_cast(bf16x8, w);
        o0 = __builtin_amdgcn_mfma_f32_32x32x16_bf16(va[2 * s], pb, o0, 0, 0, 0);
        o1 = __builtin_amdgcn_mfma_f32_32x32x16_bf16(va[2 * s + 1], pb, o1, 0, 0, 0); }
}
__device__ __forceinline__ void att_merge(f32x16& o0, f32x16& o1, float mrun, float lrun, int qpos, int brmode, bf16* OPh, float* MLh, bf16* outp, int h) {
    bf16* op = OPh + (size_t)qpos * 64 + 8 * h;
    if (brmode != 0) {
        const f32x2v mlp = gld<f32x2v>(MLh + 2 * (size_t)qpos);
        v4u pv[4];
#pragma unroll
        for (int g = 0; g < 4; ++g) pv[g] = gld<v4u>(op + 16 * g);
        const float mnew = fmaxf(mrun, mlp.x), ao = __builtin_amdgcn_exp2f(mlp.x - mnew), an = __builtin_amdgcn_exp2f(mrun - mnew);
        lrun = lrun * an + mlp.y * ao; mrun = mnew;
#pragma unroll
        for (int g = 0; g < 4; ++g) {
            const auto rx = __builtin_amdgcn_permlane32_swap(pv[g].x, pv[g].z, false, false);
            const auto ry = __builtin_amdgcn_permlane32_swap(pv[g].y, pv[g].w, false, false);
            const unsigned wa[2] = {rx[0], ry[0]}, wb[2] = {rx[1], ry[1]};
#pragma unroll
            for (int j = 0; j < 2; ++j) {
                const float a0 = __builtin_bit_cast(float, wa[j] << 16), a1 = __builtin_bit_cast(float, wa[j] & 0xffff0000u);
                const float b0 = __builtin_bit_cast(float, wb[j] << 16), b1 = __builtin_bit_cast(float, wb[j] & 0xffff0000u);
                if (g < 2) { o0[8 * g + 2 * j] = o0[8 * g + 2 * j] * an + a0 * ao; o0[8 * g + 2 * j + 1] = o0[8 * g + 2 * j + 1] * an + a1 * ao;
                             o0[8 * g + 4 + 2 * j] = o0[8 * g + 4 + 2 * j] * an + b0 * ao; o0[8 * g + 4 + 2 * j + 1] = o0[8 * g + 4 + 2 * j + 1] * an + b1 * ao; }
                else { const int e = 8 * (g - 2);
                       o1[e + 2 * j] = o1[e + 2 * j] * an + a0 * ao; o1[e + 2 * j + 1] = o1[e + 2 * j + 1] * an + a1 * ao;
                       o1[e + 4 + 2 * j] = o1[e + 4 + 2 * j] * an + b0 * ao; o1[e + 4 + 2 * j + 1] = o1[e + 4 + 2 * j + 1] * an + b1 * ao; }
            }
        }
    }
    float sc = 1.f; bf16* dst = op;
    if (brmode != 2) { if (h == 0) gst<f32x2v>(MLh + 2 * (size_t)qpos, (f32x2v){mrun, lrun}); }
    else { sc = 1.f / lrun; dst = outp + (size_t)qpos * 1024 + 8 * h; }
#pragma unroll
    for (int g = 0; g < 4; ++g) {
        unsigned ax, ay, bx, by;
        if (g < 2) { ax = pk2(o0[8 * g] * sc, o0[8 * g + 1] * sc); ay = pk2(o0[8 * g + 2] * sc, o0[8 * g + 3] * sc); bx = pk2(o0[8 * g + 4] * sc, o0[8 * g + 5] * sc); by = pk2(o0[8 * g + 6] * sc, o0[8 * g + 7] * sc); }
        else { const int e = 8 * (g - 2); ax = pk2(o1[e] * sc, o1[e + 1] * sc); ay = pk2(o1[e + 2] * sc, o1[e + 3] * sc); bx = pk2(o1[e + 4] * sc, o1[e + 5] * sc); by = pk2(o1[e + 6] * sc, o1[e + 7] * sc); }
        const auto rx = __builtin_amdgcn_permlane32_swap(ax, bx, false, false);
        const auto ry = __builtin_amdgcn_permlane32_swap(ay, by, false, false);
        gst<v4u>(dst + 16 * g, (v4u){rx[0], ry[0], rx[1], ry[1]});
    }
}

__device__ __forceinline__ void att_phase(unsigned char* ws, LAS unsigned char* lds, int lane, int wave, int G) {
    const bf16* Qa = (const bf16*)(ws + WS_BIG); const bf16* Ka = Qa + SEG; const bf16* Va = Qa + 2 * SEG;
    float* OP = (float*)(ws + WS_OP); float* ML = (float*)(ws + WS_ML); bf16* MO = (bf16*)(ws + WS_H);
    LAS unsigned char* vlds = lds + wave * 20480;
    const int nun = G == 256 ? 2 : (512 + G - 1) / G;
    const int qc = lane & 31, h = lane >> 5;
    const int i16 = lane & 15, tq = i16 >> 2, tp = i16 & 3, blk = (lane >> 4) & 1;
    LAS const unsigned char* trb = vlds + (4 * h + tq) * VP + (16 * blk) * 2 + 8 * tp;
    bf16x8 qfA[4], qfB[4];
#define ATT_DMA_KV(J, kb, slot) do { _Pragma("unroll") for (int i_ = 0; i_ < 4; ++i_) { const int key_ = 8 * i_ + (lane >> 3); int kp_ = (J).pos0 + (32 * (kb) + key_ - 128) * (J).d; kp_ = kp_ < 0 ? 0 : kp_; \
        __builtin_amdgcn_global_load_lds((const GAS unsigned*)(Ka + ((J).hb + (size_t)kp_) * 64 + (((lane & 7) ^ ((lane >> 3) & 7)) * 8)), (LAS unsigned*)(vlds + (slot) * 4096 + i_ * 1024), 16, 0, 0); \
        __builtin_amdgcn_global_load_lds((const GAS unsigned*)(Va + ((J).hb + (size_t)kp_) * 64 + (lane & 7) * 8), (LAS unsigned*)(vlds + 8192 + (slot) * 4096 + i_ * 1024), 16, 0, 0); } } while (0)
#define ATT_DMA_Q(J, set) do { _Pragma("unroll") for (int i_ = 0; i_ < 4; ++i_) { const int qp_ = (J).pos0 + (32 * (set) + 8 * i_ + (lane >> 3)) * (J).d; \
        __builtin_amdgcn_global_load_lds((const GAS unsigned*)(Qa + ((J).hb + (size_t)qp_) * 64 + (((lane & 7) ^ ((lane >> 3) & 7)) * 8)), (LAS unsigned*)(vlds + 16384 + i_ * 1024), 16, 0, 0); } } while (0)
#define ATT_READ_Q(dst) do { _Pragma("unroll") for (int kk_ = 0; kk_ < 4; ++kk_) dst[kk_] = *(LAS const bf16x8*)(vlds + 16384 + qc * 128 + (((2 * kk_ + h) ^ (qc & 7)) << 4)); } while (0)
    LAS const unsigned char* kfb = vlds + qc * 128;
    AttJob P, N;
    bool have = att_params(0, nun, G, wave, P);
    int sb = 0;
    if (have) { ATT_DMA_KV(P, 0, 0); ATT_DMA_Q(P, 0); asm volatile("s_waitcnt vmcnt(0)" ::: "memory"); ATT_READ_Q(qfA); LDS_WAIT();
                ATT_DMA_Q(P, 1); asm volatile("s_waitcnt vmcnt(0)" ::: "memory"); ATT_READ_Q(qfB); LDS_WAIT(); }
#pragma unroll 1
    for (int q = 0; have; ++q) {
        const bool hn = att_params(q + 1, nun, G, wave, N);
        const int pos0 = P.pos0, d = P.d, brmode = P.brmode;
        bf16* OPh = (bf16*)OP + P.hb * 64; float* MLh = ML + P.hb * 2; bf16* outp = MO + (size_t)P.b * SEQ * 1024 + P.head * 64;
        float mA = -1e30f, lA = 0.f, mB = -1e30f, lB = 0.f;
        f32x16 oA0, oA1, oB0, oB1;
#pragma unroll
        for (int i = 0; i < 16; ++i) { oA0[i] = 0.f; oA1[i] = 0.f; oB0[i] = 0.f; oB1[i] = 0.f; }
        int kminA = 0, kminB = 0;
        { const int t0 = 128 * d - pos0; if (t0 > 0) kminA = (t0 + d - 1) / d; const int t1 = 96 * d - pos0; if (t1 > 0) kminB = (t1 + d - 1) / d; }
        const int mloA = qc > kminA ? qc : kminA, mloB = qc > kminB ? qc : kminB;
#pragma unroll
        for (int kb = 0; kb < 6; ++kb) {
            asm volatile("s_waitcnt vmcnt(0)" ::: "memory");
            if (kb < 5) ATT_DMA_KV(P, kb + 1, sb ^ 1);
            else if (hn) ATT_DMA_KV(N, 0, sb ^ 1);
            if (kb == 3 && hn) ATT_DMA_Q(N, 0);
            bf16x8 kf[4], va[4];
#pragma unroll
            for (int kk = 0; kk < 4; ++kk) kf[kk] = *(LAS const bf16x8*)(kfb + sb * 4096 + (((2 * kk + h) ^ (qc & 7)) << 4));
            LAS const unsigned char* trs = trb + 8192 + sb * 4096;
#pragma unroll
            for (int s = 0; s < 2; ++s) {
                const s16x4 lo0 = vtr(trs + (16 * s) * VP), hi0 = vtr(trs + (16 * s + 8) * VP);
                const s16x4 lo1 = vtr(trs + (16 * s) * VP + 64), hi1 = vtr(trs + (16 * s + 8) * VP + 64);
                va[2 * s] = (bf16x8){lo0[0], lo0[1], lo0[2], lo0[3], hi0[0], hi0[1], hi0[2], hi0[3]};
                va[2 * s + 1] = (bf16x8){lo1[0], lo1[1], lo1[2], lo1[3], hi1[0], hi1[1], hi1[2], hi1[3]};
            }
            if (kb <= 4) {
                att_block(kf, qfA, va, oA0, oA1, mA, lA, kb == 0 || kb == 4 || kminA > 32 * kb, mloA - 4 * h - 32 * kb, qc + 128 - 4 * h - 32 * kb);
                if (kb == 4 && hn) { ATT_READ_Q(qfA); LDS_WAIT(); ATT_DMA_Q(N, 1); }
            }
            if (kb >= 1) {
                att_block(kf, qfB, va, oB0, oB1, mB, lB, kb == 1 || kb == 5 || kminB > 32 * (kb - 1), mloB - 4 * h - 32 * (kb - 1), qc + 128 - 4 * h - 32 * (kb - 1));
                if (kb == 5 && hn) ATT_READ_Q(qfB);
            }
            LDS_WAIT();
            sb ^= 1;
            __builtin_amdgcn_sched_barrier(0);
        }
        att_merge(oA0, oA1, mA, lA, pos0 + qc * d, brmode, OPh, MLh, outp, h);
        att_merge(oB0, oB1, mB, lB, pos0 + (32 + qc) * d, brmode, OPh, MLh, outp, h);
        if (P.bar_after) { asm volatile("s_waitcnt vmcnt(0) lgkmcnt(0)" ::: "memory"); __syncthreads(); __builtin_amdgcn_fence(__ATOMIC_ACQUIRE, "agent"); }
        P = N; have = hn;
    }
#undef ATT_DMA_KV
#undef ATT_DMA_Q
#undef ATT_READ_Q
}

constexpr int RAWP = 272, KTP = 144;
__device__ __forceinline__ void hg_fetch(const bf16* src, int tok0, int hh, int tid, v4u (&r)[2]) {
#pragma unroll
    for (int i = 0; i < 2; ++i) { const int idx = tid + 512 * i, row = idx >> 4, ch = idx & 15;
        r[i] = gld<v4u>(src + (size_t)(tok0 + row) * 512 + hh * 128 + ch * 8); }
}
__device__ __forceinline__ void hg_put(const v4u (&r)[2], LAS unsigned char* dst, int tid) {
#pragma unroll
    for (int i = 0; i < 2; ++i) { const int idx = tid + 512 * i, row = idx >> 4, ch = idx & 15; *(LAS v4u*)(dst + row * RAWP + ch * 16) = r[i]; }
}
__device__ __forceinline__ void hg_job(int job, int& hh, int& tok0) { const int bh = job >> 7, ch = job & 127; hh = bh & 3; tok0 = (bh >> 2) * SEQ + ch * 64; }
__device__ __forceinline__ void hg_decay(LAS const unsigned char* rawF, LAS float* part, float lbc, int c, int j, float (&bc)[16], float (&kv)[16], float& tot, float& bref) {
    float run = 0.f;
#pragma unroll
    for (int i = 0; i < 16; ++i) { const float lf = h2f(*(LAS const unsigned short*)(rawF + (16 * j + i) * RAWP + 2 * c)); kv[i] = 1.f - __expf(lf); run += lf; bc[i] = run; }
    part[j * 128 + c] = run;
    __syncthreads();
    const float p0 = part[c], p1 = part[128 + c], p2 = part[256 + c], p3 = part[384 + c];
    const float pre = j == 0 ? 0.f : (j == 1 ? p0 : (j == 2 ? p0 + p1 : p0 + p1 + p2));
#pragma unroll
    for (int i = 0; i < 16; ++i) bc[i] += pre;
    tot = (p0 + p1) + (p2 + p3); bref = p0 + p1;
}
__device__ __forceinline__ void st16bf(LAS unsigned char* p, const float (&v)[16]) {
    v4u a, b; a.x = pk2(v[0], v[1]); a.y = pk2(v[2], v[3]); a.z = pk2(v[4], v[5]); a.w = pk2(v[6], v[7]);
    b.x = pk2(v[8], v[9]); b.y = pk2(v[10], v[11]); b.z = pk2(v[12], v[13]); b.w = pk2(v[14], v[15]);
    *(LAS v4u*)p = a; *(LAS v4u*)(p + 16) = b;
}

__device__ __forceinline__ void hgrn1_phase(unsigned char* ws, const float* lbl, LAS unsigned char* lds, int tid, int lane, int wave, int G) {
    const bf16* HF = (const bf16*)(ws + WS_BIG) + 4 * SEG; const bf16* HI = (const bf16*)(ws + WS_BIG) + 5 * SEG;
    bf16* DS = (bf16*)(ws + WS_DS); float* HDEC = (float*)(ws + WS_HDEC);
    LAS unsigned char* rawF = lds; LAS unsigned char* rawI = lds + 17408; LAS unsigned char* KT = lds + 34816; LAS unsigned char* VT = KT + 18432; LAS float* part = (LAS float*)(VT + 18432);
    const int c = tid & 127, j = tid >> 7, fr = lane & 15, fq = lane >> 4;
    v4u rF[2], rI[2];
    { int hh0, t0; hg_job(blockIdx.x, hh0, t0); if ((int)blockIdx.x < 4096) { hg_fetch(HF, t0, hh0, tid, rF); hg_fetch(HI, t0, hh0, tid, rI); } }
    for (int job = blockIdx.x; job < 4096; job += G) {
        int hh, tok0; hg_job(job, hh, tok0);
        hg_put(rF, rawF, tid); hg_put(rI, rawI, tid);
        __syncthreads();
        if (job + G < 4096) { int hn, tn; hg_job(job + G, hn, tn); hg_fetch(HF, tn, hn, tid, rF); hg_fetch(HI, tn, hn, tid, rI); }
        float bc[16], kv[16], tot, bref;
        hg_decay(rawF, part, lbl[hh * 128 + c], c, j, bc, kv, tot, bref);
        float tmp[16];
#pragma unroll
        for (int i = 0; i < 16; ++i) tmp[i] = kv[i] * __expf(tot - bc[i]);
        st16bf(KT + c * KTP + j * 32, tmp);
#pragma unroll
        for (int i = 0; i < 16; ++i) tmp[i] = bf2f(*(LAS const unsigned short*)(rawI + (16 * j + i) * RAWP + 2 * c));
        st16bf(VT + c * KTP + j * 32, tmp);
        if (j == 0) gst<float>(HDEC + (size_t)job * 128 + c, __expf(tot));
        __syncthreads();
        bf16x8 af[2];
#pragma unroll
        for (int kk = 0; kk < 2; ++kk) af[kk] = *(LAS const bf16x8*)(KT + (16 * wave + fr) * KTP + (8 * fq + 32 * kk) * 2);
#pragma unroll
        for (int n = 0; n < 8; ++n) {
            f32x4 cacc = (f32x4){0.f, 0.f, 0.f, 0.f};
#pragma unroll
            for (int kk = 0; kk < 2; ++kk) { const bf16x8 bfr = *(LAS const bf16x8*)(VT + (16 * n + fr) * KTP + (8 * fq + 32 * kk) * 2);
                cacc = __builtin_amdgcn_mfma_f32_16x16x32_bf16(af[kk], bfr, cacc, 0, 0, 0); }
            v2u w; w.x = pk2(cacc[0], cacc[1]); w.y = pk2(cacc[2], cacc[3]);
            gst<v2u>(DS + (size_t)job * 16384 + (n * 4 + (wave >> 1)) * 512 + (fr + 16 * (2 * (wave & 1) + (fq >> 1))) * 8 + 4 * (fq & 1), w);
        }
        __syncthreads();
    }
}

__device__ __forceinline__ void hgrn2_phase(unsigned char* ws, int tid, int G) {
    bf16* DS = (bf16*)(ws + WS_DS); const float* HDEC = (const float*)(ws + WS_HDEC);
    for (int gt = blockIdx.x * 512 + tid; gt < 32 * 4096; gt += G * 512) {
        const int bh = gt >> 12, e4 = gt & 4095; const int lin = 4 * e4, dk = 32 * ((lin >> 9) & 3) + 8 * (((lin & 511) >> 3) >> 4) + (lin & 7);
        bf16* p = DS + (size_t)bh * 128 * 16384 + 4 * e4; const float* dp = HDEC + (size_t)bh * 128 * 128 + dk;
        f32x4 s = (f32x4){0.f, 0.f, 0.f, 0.f};
#pragma unroll 1
        for (int c0 = 0; c0 < 128; c0 += 16) {
            v2u w[16]; f32x4 dc[16];
#pragma unroll
            for (int i = 0; i < 16; ++i) { w[i] = gld<v2u>(p + (size_t)(c0 + i) * 16384); dc[i] = gld<f32x4>(dp + (c0 + i) * 128); }
#pragma unroll
            for (int i = 0; i < 16; ++i) {
                v2u o; o.x = pk2(s.x, s.y); o.y = pk2(s.z, s.w); gst<v2u>(p + (size_t)(c0 + i) * 16384, o);
                const f32x4 dv = (f32x4){__builtin_bit_cast(float, w[i].x << 16), __builtin_bit_cast(float, w[i].x & 0xffff0000u), __builtin_bit_cast(float, w[i].y << 16), __builtin_bit_cast(float, w[i].y & 0xffff0000u)};
                s = dc[i] * s + dv;
            }
        }
    }
}

__device__ __forceinline__ void hgrn3_phase(unsigned char* ws, const float* lbl, const float* nw, LAS unsigned char* lds, int tid, int lane, int wave, int G) {
    const bf16* HQ = (const bf16*)(ws + WS_BIG) + 3 * SEG; const bf16* HF = HQ + SEG; const bf16* HI = HQ + 2 * SEG; const bf16* HG = HQ + 3 * SEG;
    const bf16* DS = (const bf16*)(ws + WS_DS); bf16* MO = (bf16*)(ws + WS_H);
    LAS unsigned char* rawQ = lds; LAS unsigned char* rawF = lds + 17408; LAS unsigned char* rawI = lds + 2 * 17408;
    LAS unsigned char* QT = lds + 3 * 17408; LAS unsigned char* KT = QT + 17408; LAS unsigned char* QH = KT + 17408;
    LAS unsigned char* VT = QH + 17408;
    LAS unsigned char* PT = VT + 18432;
    LAS float* part = (LAS float*)(PT + 9216);
    LAS float* ssq = part + 512;
    const int c = tid & 127, j = tid >> 7, fr = lane & 15, fq = lane >> 4;
    const int tt = wave >> 1, wh = wave & 1;
    v4u rQ[2], rF[2], rI[2];
    { int hh0, t0; hg_job(blockIdx.x, hh0, t0); if ((int)blockIdx.x < 4096) { hg_fetch(HQ, t0, hh0, tid, rQ); hg_fetch(HF, t0, hh0, tid, rF); hg_fetch(HI, t0, hh0, tid, rI); } }
    for (int job = blockIdx.x; job < 4096; job += G) {
        int hh, tok0; hg_job(job, hh, tok0);
        hg_put(rQ, rawQ, tid); hg_put(rF, rawF, tid); hg_put(rI, rawI, tid);
        bf16x8 sf[4][4];
#pragma unroll
        for (int n = 0; n < 4; ++n)
#pragma unroll
            for (int kk = 0; kk < 4; ++kk) sf[n][kk] = gld<bf16x8>(DS + (size_t)job * 16384 + ((4 * wh + n) * 4 + kk) * 512 + lane * 8);
        __syncthreads();
        if (job + G < 4096) { int hn, tn; hg_job(job + G, hn, tn); hg_fetch(HQ, tn, hn, tid, rQ); hg_fetch(HF, tn, hn, tid, rF); hg_fetch(HI, tn, hn, tid, rI); }
        {
            float bc[16], kv[16], tot, bref;
            hg_decay(rawF, part, lbl[hh * 128 + c], c, j, bc, kv, tot, bref);
#pragma unroll
            for (int i = 0; i < 16; ++i) {
                const int t = 16 * j + i;
                const float q = bf2f(*(LAS const unsigned short*)(rawQ + t * RAWP + 2 * c));
                const float dq = fminf(fmaxf(bc[i] - bref, -80.f), 80.f);
                *(LAS unsigned short*)(QT + t * RAWP + 2 * c) = (unsigned short)pk2(q * __expf(dq), 0.f);
                *(LAS unsigned short*)(KT + t * RAWP + 2 * c) = (unsigned short)pk2(kv[i] * __expf(-dq), 0.f);
                *(LAS unsigned short*)(QH + t * RAWP + 2 * c) = (unsigned short)pk2(q * __expf(bc[i]), 0.f);
            }
            float tmp[16];
#pragma unroll
            for (int i = 0; i < 16; ++i) tmp[i] = bf2f(*(LAS const unsigned short*)(rawI + (16 * j + i) * RAWP + 2 * c));
            st16bf(VT + c * KTP + j * 32, tmp);
        }
        __syncthreads();
        {
            bf16x8 qfr[4];
#pragma unroll
            for (int kk = 0; kk < 4; ++kk) qfr[kk] = *(LAS const bf16x8*)(QT + (16 * tt + fr) * RAWP + (8 * fq + 32 * kk) * 2);
#pragma unroll
            for (int si = 0; si < 2; ++si) {
                const int stile = 2 * wh + si;
                f32x4 cacc = (f32x4){0.f, 0.f, 0.f, 0.f};
#pragma unroll
                for (int kk = 0; kk < 4; ++kk) { const bf16x8 kfr = *(LAS const bf16x8*)(KT + (16 * stile + fr) * RAWP + (8 * fq + 32 * kk) * 2);
                    cacc = __builtin_amdgcn_mfma_f32_16x16x32_bf16(kfr, qfr[kk], cacc, 0, 0, 0); }
                const int t = 16 * tt + fr, s0 = 16 * stile + 4 * fq;
#pragma unroll
                for (int i = 0; i < 4; ++i) cacc[i] = (s0 + i <= t) ? cacc[i] : 0.f;
                v2u w; w.x = pk2(cacc[0], cacc[1]); w.y = pk2(cacc[2], cacc[3]);
                *(LAS v2u*)(PT + t * KTP + s0 * 2) = w;
            }
        }
        __syncthreads();
        v2u gpre[4];
#pragma unroll
        for (int n = 0; n < 4; ++n) gpre[n] = gld<v2u>(HG + (size_t)(tok0 + 16 * tt + fr) * 512 + hh * 128 + 16 * (4 * wh + n) + 4 * fq);
        f32x4 oacc[4];
        {
            bf16x8 pfr[2], qh[4];
#pragma unroll
            for (int kk = 0; kk < 2; ++kk) pfr[kk] = *(LAS const bf16x8*)(PT + (16 * tt + fr) * KTP + (8 * fq + 32 * kk) * 2);
#pragma unroll
            for (int kk = 0; kk < 4; ++kk) qh[kk] = *(LAS const bf16x8*)(QH + (16 * tt + fr) * RAWP + (8 * fq + 32 * kk) * 2);
#pragma unroll
            for (int n = 0; n < 4; ++n) {
                f32x4 cacc = (f32x4){0.f, 0.f, 0.f, 0.f};
#pragma unroll
                for (int kk = 0; kk < 2; ++kk) { const bf16x8 vfr = *(LAS const bf16x8*)(VT + (16 * (4 * wh + n) + fr) * KTP + (8 * fq + 32 * kk) * 2);
                    cacc = __builtin_amdgcn_mfma_f32_16x16x32_bf16(vfr, pfr[kk], cacc, 0, 0, 0); }
#pragma unroll
                for (int kk = 0; kk < 4; ++kk) cacc = __builtin_amdgcn_mfma_f32_16x16x32_bf16(sf[n][kk], qh[kk], cacc, 0, 0, 0);
                oacc[n] = cacc;
            }
        }
        float sq = 0.f;
#pragma unroll
        for (int n = 0; n < 4; ++n) sq += (oacc[n][0] * oacc[n][0] + oacc[n][1] * oacc[n][1]) + (oacc[n][2] * oacc[n][2] + oacc[n][3] * oacc[n][3]);
        sq += __shfl_xor(sq, 16); sq += __shfl_xor(sq, 32);
        if (fq == 0) ssq[wh * 64 + 16 * tt + fr] = sq;
        __syncthreads();
        {
            const int t = 16 * tt + fr;
            const float rinv = 1.f / sqrtf((ssq[t] + ssq[64 + t]) * (1.f / 128.f) + RMS_EPS);
#pragma unroll
            for (int n = 0; n < 4; ++n) {
                const int dv = 16 * (4 * wh + n) + 4 * fq;
                const f32x4 nwv = gld<f32x4>(nw + hh * 128 + dv);
                const v2u gw_ = gpre[n];
                const f32x4 gv = (f32x4){__builtin_bit_cast(float, gw_.x << 16), __builtin_bit_cast(float, gw_.x & 0xffff0000u), __builtin_bit_cast(float, gw_.y << 16), __builtin_bit_cast(float, gw_.y & 0xffff0000u)};
                const f32x4 ov = oacc[n] * rinv * nwv * gv;
                v2u w; w.x = pk2(ov[0], ov[1]); w.y = pk2(ov[2], ov[3]);
                gst<v2u>(MO + (size_t)(tok0 + t) * 1024 + 512 + hh * 128 + dv, w);
            }
        }
        __syncthreads();
    }
}

__device__ __forceinline__ void grid_bar(unsigned* ctrs, unsigned gen, int tid, unsigned G) {
    asm volatile("s_waitcnt vmcnt(0) lgkmcnt(0)" ::: "memory");
    __syncthreads();
    if (tid == 0) {
        __builtin_amdgcn_fence(__ATOMIC_RELEASE, "agent");
        if ((G & 7u) == 0u) {
            const unsigned g = blockIdx.x & 7u, gs = G >> 3;
            const unsigned old = __hip_atomic_fetch_add(ctrs + 64 * (1 + g), 1u, __ATOMIC_RELAXED, __HIP_MEMORY_SCOPE_AGENT);
            if (old + 1u == gen * gs) __hip_atomic_fetch_add(ctrs, 1u, __ATOMIC_RELAXED, __HIP_MEMORY_SCOPE_AGENT);
            while (__hip_atomic_load(ctrs, __ATOMIC_RELAXED, __HIP_MEMORY_SCOPE_AGENT) < gen * 8u) __builtin_amdgcn_s_sleep(1);
        } else {
            __hip_atomic_fetch_add(ctrs, 1u, __ATOMIC_RELAXED, __HIP_MEMORY_SCOPE_AGENT);
            while (__hip_atomic_load(ctrs, __ATOMIC_RELAXED, __HIP_MEMORY_SCOPE_AGENT) < gen * G) __builtin_amdgcn_s_sleep(1);
        }
        __builtin_amdgcn_fence(__ATOMIC_ACQUIRE, "agent");
    }
    __syncthreads();
}
constexpr int N_PHASES = 26;
__global__ void __launch_bounds__(512, 2) mk_fwd(Args a) {
    extern __shared__ __attribute__((aligned(16))) unsigned char lds_raw[];
    LAS unsigned char* lds = (LAS unsigned char*)lds_raw;
    int rep = 0; unsigned nbar = 0u;
    const int wave_s = __builtin_amdgcn_readfirstlane((int)threadIdx.x >> 6);
    for (int ph = a.ph_lo; ph < a.ph_hi; ++ph) {
        int tid; { int ln_; asm volatile("v_mbcnt_lo_u32_b32 %0, -1, 0\n\tv_mbcnt_hi_u32_b32 %0, -1, %0" : "=v"(ln_)); tid = wave_s * 64 + ln_; }
        int G = gridDim.x; asm volatile("" : "+s"(G));
        int bid = blockIdx.x; asm volatile("" : "+s"(bid));
        unsigned char* ws = a.ws; asm volatile("" : "+s"(ws));
        float* outp = a.out; asm volatile("" : "+s"(outp));
        const float* xin = (const float*)a.in[0]; asm volatile("" : "+s"(xin));
        const float* ln_g = (const float*)a.in[3]; asm volatile("" : "+s"(ln_g));
        const float* ln_b = (const float*)a.in[4]; asm volatile("" : "+s"(ln_b));
        const int wave = wave_s;
#define LANE_() ({ int l_ = tid & 63; asm volatile("" : "+v"(l_)); l_; })
        float* ada = (float*)(ws + WS_ADA); float* stats = (float*)(ws + WS_STATS);
        bf16* Hb = (bf16*)(ws + WS_H); bf16* ACT = (bf16*)(ws + WS_BIG);
        const int l = ph < 2 ? 0 : (ph - 2) / 12, k = ph < 2 ? ph : 2 + (ph - 2) % 12;
        unsigned char* wl = ws + WS_W + (size_t)l * W_LAYER;
        const float* ada_l = ada + (size_t)l * 8 * NADA;
#ifdef PHMASK
        if (!((PHMASK >> k) & 1)) continue;
#endif
#ifndef SKIPMASK
#define SKIPMASK 0x0
#endif
        if ((SKIPMASK >> k) & 1) continue;
        switch (k) {
        case 0: prologue_phase(a, lds, tid, LANE_(), wave, G); break;
        case 1: lnmod_phase<0>(xin, nullptr, nullptr, Hb, nullptr, nullptr, ada, LANE_(), wave, G); break;
        case 2: case 11: {
            pg8::Gemm g{Hb, (const bf16*)(wl + (k == 2 ? W_1IN : W_2IN)), M, 2 * FF, D}; pg8::StaticOrder S; S.init(M, 2 * FF, G, bid);
            pg8::EpiSwiglu E{ACT, FF};
            pg8::gemm_phase<pg8::EpiSwiglu, pg8::StaticOrder, true, true>(lds, g, S, E, tid);
        } break;
        case 3: case 9: case 12: {
            const int sub = k == 3 ? 0 : (k == 9 ? 1 : 2);
            const bf16* A = k == 9 ? Hb : ACT; const int K = k == 9 ? D : FF;
            const bf16* Bt = (const bf16*)(wl + (k == 3 ? W_1OUT : (k == 9 ? W_MOUT : W_2OUT)));
            const int mode = (l == 0 && sub == 0) ? 0 : 1;
            const int pl = sub == 0 ? l - 1 : l, ps = sub == 0 ? 2 : sub - 1;
            const int pidx = mode ? (pl * 3 + ps) : 0;
            pg8::Gemm g{A, Bt, M, D, K}; pg8::StaticOrder S; S.init(M, D, G, bid);
            pg8::EpiResid E{xin, outp, stats, ln_g + pidx * D, ln_b + pidx * D, ada_l + sub * 3072 + 2048, DN_ALPHA, sub == 1 ? 1.0f : 0.5f, mode, (unsigned)(size_t)(lds + 131072)};
            pg8::gemm_phase<pg8::EpiResid, pg8::StaticOrder, true, true>(lds, g, S, E, tid);
        } break;
        case 4: case 10: case 13: {
            const int sub = k == 4 ? 0 : (k == 10 ? 1 : 2);
            const float* lg = ln_g + (l * 3 + sub) * D; const float* lb = ln_b + (l * 3 + sub) * D;
            if (k == 13 && l == 1) lnmod_phase<2>(outp, outp, nullptr, nullptr, lg, lb, nullptr, LANE_(), wave, G);
            else { const float* am = k == 13 ? ada + (size_t)(l + 1) * 8 * NADA : ada_l + (sub + 1) * 3072;
                lnmod_phase<1>(outp, nullptr, stats, Hb, lg, lb, am, LANE_(), wave, G); }
        } break;
        case 5: {
            pg8::Gemm g{Hb, (const bf16*)(wl + W_MIN), M, NIN, D}; pg8::StaticOrder S; S.init(M, NIN, G, bid);
            pg8::EpiMixIn E{(bf16*)(ws + WS_BIG), (const float*)(ws + WS_ROPE), (const float*)(ws + WS_LB) + l * 512};
            pg8::gemm_phase<pg8::EpiMixIn, pg8::StaticOrder, true, true>(lds, g, S, E, tid);
        } break;
#ifndef SKIP_ATT
#define SKIP_ATT 0
#endif
        case 6: { if (!SKIP_ATT) att_phase(ws, lds, LANE_(), wave, G); __syncthreads();
                int tid2; { int ln2_; asm volatile("v_mbcnt_lo_u32_b32 %0, -1, 0\n\tv_mbcnt_hi_u32_b32 %0, -1, %0" : "=v"(ln2_)); tid2 = wave_s * 64 + ln2_; }
            unsigned char* ws2 = a.ws; asm volatile("" : "+s"(ws2));
            hgrn1_phase(ws2, (const float*)(ws2 + WS_LB) + l * 512, lds, tid2, tid2 & 63, wave_s, G); } break;
        case 7: hgrn2_phase(ws, tid, G); break;
        case 8: hgrn3_phase(ws, (const float*)(ws + WS_LB) + l * 512, (const float*)a.in[13] + l * 512, lds, tid, LANE_(), wave, G); break;
        default: break;
        }
#ifndef REPMASK
#define REPMASK 0
#endif
        if (((REPMASK >> k) & 1) && rep == 0 && !(k == 13 && l == 1)) { rep = 1; --ph; } else rep = 0;
        if (ph + 1 < a.ph_hi) {
            if (nbar == 0u) { cg::this_grid().sync(); nbar = 1u; }
            else { grid_bar((unsigned*)(a.ws + WS_LB + 8192), nbar, tid, gridDim.x); ++nbar; }
        }
    }
}

#ifndef MK_PER_PHASE
#define MK_PER_PHASE 0
#endif
extern "C" void kernel_launch(void* const* d_in, const int* in_sizes, int n_in, void* d_out, int out_size, void* d_ws, size_t ws_size, hipStream_t stream) {
    static int grid = 0;
    if (grid == 0) {
        if (n_in != 15 || in_sizes[0] != M * D || out_size != M * D || ws_size < WS_END) {
            fprintf(stderr, "kernel_launch: unexpected shapes (n_in %d, in0 %d, out %d, ws %zu, need %zu)\n", n_in, n_in > 0 ? in_sizes[0] : -1, out_size, ws_size, (size_t)WS_END); grid = -1; return; }
        int dev = 0, cus = 0, per_cu = 0;
        hipGetDevice(&dev); hipDeviceGetAttribute(&cus, hipDeviceAttributeMultiprocessorCount, dev);
        hipFuncSetAttribute((const void*)mk_fwd, hipFuncAttributeMaxDynamicSharedMemorySize, LDS_BYTES);
        hipOccupancyMaxActiveBlocksPerMultiprocessor(&per_cu, (const void*)mk_fwd, 512, LDS_BYTES);
        if (per_cu < 1) { fprintf(stderr, "kernel_launch: occupancy query says %d blocks per CU\n", per_cu); per_cu = 1; }
        (void)hipGetLastError();
        grid = cus * 1;
    }
    if (grid < 0) return;
    Args a{};
    for (int i = 0; i < 15; ++i) a.in[i] = d_in[i];
    a.out = (float*)d_out; a.ws = (unsigned char*)d_ws;
    for (int j = 0; j < 8; ++j) a.invf[j] = (float)std::pow(500000.0, -(double)j / 8.0);
#if MK_PER_PHASE
    for (int ph = 0; ph < N_PHASES; ++ph) { a.ph_lo = ph; a.ph_hi = ph + 1; hipLaunchKernelGGL(mk_fwd, dim3(grid), dim3(512), LDS_BYTES, stream, a); }
#else
    a.ph_lo = 0; a.ph_hi = N_PHASES;
    void* args[] = {&a};
    hipError_t e = hipLaunchCooperativeKernel((const void*)mk_fwd, dim3(grid), dim3(512), args, LDS_BYTES, stream);
    if (e != hipSuccess) fprintf(stderr, "cooperative launch failed: %s (grid %d)\n", hipGetErrorString(e), grid);
#endif
}
```

```cpp
#include <hip/hip_runtime.h>
#include <hip/hip_cooperative_groups.h>
#include <cstdio>
#include <cstdint>
#include <cmath>
namespace cg = cooperative_groups;
namespace pg8 {
#define PG8_LAS __attribute__((address_space(3)))
typedef unsigned short bf16_t;
typedef short bf16x8 __attribute__((ext_vector_type(8)));
typedef float f32x4 __attribute__((ext_vector_type(4)));
typedef unsigned u32x4 __attribute__((ext_vector_type(4)));
constexpr int BM = 256, BK = 64, HALF = 128, HTB = HALF * BK * 2  , STAGE_BYTES = 8 * HTB, NXCD = 8, WGM = 8;

__host__ __device__ __forceinline__ int lds_byte(int r, int c) { const int st = (r >> 4) * 2 + (c >> 5), rr = r & 15, cc = c & 31, ob = rr * 64 + cc * 2; return st * 1024 + (ob ^ (((ob >> 9) & 1) << 5)); }
__host__ __device__ __forceinline__ void stage_rc(int b, int& R, int& C) { const int st = b / 1024, sb = b % 1024, swz = sb ^ (((sb >> 9) & 1) << 5); R = (st >> 1) * 16 + swz / 64; C = (st & 1) * 32 + (swz % 64) / 2; }
__host__ __device__ __forceinline__ int perm32(int rho) { const int n = rho >> 4, i = rho & 15; return 8 * (i >> 2) + 4 * n + (i & 3); }

struct Unit { int pm, pn; };
struct Gemm { const bf16_t* A; const bf16_t* Bt; int M, N, K; };

struct StaticOrder {
    int nM, nN, nwg, G, c;
    __host__ __device__ void init(int M, int N, int G_, int c_) { nM = M / BM; nN = N / BM; nwg = nM * nN; G = G_; c = c_; }
    __host__ __device__ bool next(int i, Unit& u) const {
        const long L = (long)i * G + c; if (L >= nwg) return false;
        int wgid = (int)L; { const int q = nwg / NXCD, r = nwg % NXCD, xcd = wgid % NXCD, off = wgid / NXCD; wgid = (xcd < r ? xcd * (q + 1) : r * (q + 1) + (xcd - r) * q) + off; }
        const int nig = WGM * nN, gid = wgid / nig, fm = gid * WGM, gsz = (nM - fm) < WGM ? (nM - fm) : WGM;
        u.pm = fm + ((wgid % nig) % gsz); u.pn = (wgid % nig) / gsz; return true;
    }
    __device__ __forceinline__ void a_ready(const Unit&) const {}
    __device__ __forceinline__ void done(const Unit&) const {}
};

typedef float f32x2c __attribute__((ext_vector_type(2))); typedef __bf16 bf16x2c __attribute__((ext_vector_type(2)));
__device__ __forceinline__ unsigned cvt_pk_bf16(float lo, float hi) { const f32x2c v = {lo, hi}; const bf16x2c b = __builtin_convertvector(v, bf16x2c); return __builtin_bit_cast(unsigned, b); }
typedef float f32x2 __attribute__((ext_vector_type(2)));
#define PG8_GAS __attribute__((address_space(1)))
typedef _Float16 f16x2_t __attribute__((ext_vector_type(2)));
__device__ __forceinline__ unsigned cvt_pk_f16(float lo, float hi) { f16x2_t v = {(_Float16)lo, (_Float16)hi}; return __builtin_bit_cast(unsigned, v); }
__device__ __forceinline__ float silu_f(float v) { return v * __builtin_amdgcn_rcpf(1.f + __expf(-v)); }

struct EpiSwiglu {
    static constexpr bool PERM = true, AFTER_DRAIN = false;
    bf16_t* O; int ldc;
    __device__ __forceinline__ void operator()(const f32x4 (&acc)[2][2][4][2], const Unit& u, int wr, int wc, int fr, int fq) const {
        const int row0 = u.pm * BM + wr * 64 + fr; const int col0 = u.pn * HALF + wc * 32 + 8 * fq;
#pragma unroll
        for (int ai = 0; ai < 2; ++ai)
#pragma unroll
            for (int m = 0; m < 4; ++m) {
                bf16_t* rowp = O + (size_t)(row0 + ai * HALF + m * 16) * ldc + col0;
                const f32x4 g0 = acc[ai][0][m][0], g1 = acc[ai][0][m][1], u0 = acc[ai][1][m][0], u1 = acc[ai][1][m][1];
                u32x4 w;
                w.x = cvt_pk_bf16(silu_f(g0[0]) * u0[0], silu_f(g0[1]) * u0[1]); w.y = cvt_pk_bf16(silu_f(g0[2]) * u0[2], silu_f(g0[3]) * u0[3]);
                w.z = cvt_pk_bf16(silu_f(g1[0]) * u1[0], silu_f(g1[1]) * u1[1]); w.w = cvt_pk_bf16(silu_f(g1[2]) * u1[2], silu_f(g1[3]) * u1[3]);
                *(PG8_GAS u32x4*)rowp = w;
            }
    }
};

struct EpiResid {
    static constexpr bool PERM = false, AFTER_DRAIN = false;
    const float* xin; float* Z; const float* stats; const float* lng; const float* lnb; const float* gate; float alpha, resw; int mode; unsigned scr;
    __device__ __forceinline__ void operator()(const f32x4 (&acc)[2][2][4][2], const Unit& u, int wr, int wc, int fr, int fq) const {
        const int b = u.pm >> 5, lane = fr + 16 * fq;
        PG8_LAS unsigned char* sw = (PG8_LAS unsigned char*)(size_t)(scr + (unsigned)(wr * 4 + wc) * 2048u);
        const int wrow = fr * 128, rrow = lane >> 3, rch = lane & 7;
        f32x4 gt[2], lg[2], lb[2];
#pragma unroll
        for (int bj = 0; bj < 2; ++bj) {
            const int c = u.pn * BM + bj * HALF + wc * 32 + 4 * rch;
            gt[bj] = (*(const PG8_GAS f32x4*)(gate + (size_t)b * 9216 + c) + 1.f) * resw;
            lg[bj] = (f32x4){1.f, 1.f, 1.f, 1.f}; lb[bj] = (f32x4){0.f, 0.f, 0.f, 0.f};
            if (mode) { lg[bj] = *(const PG8_GAS f32x4*)(lng + c); lb[bj] = *(const PG8_GAS f32x4*)(lnb + c); }
        }
#pragma unroll
        for (int ai = 0; ai < 2; ++ai)
#pragma unroll
            for (int m = 0; m < 4; ++m) {
                const int r0 = u.pm * BM + ai * HALF + wr * 64 + m * 16;
                f32x2 st2[2];
#pragma unroll
                for (int s = 0; s < 2; ++s) { st2[s] = (f32x2){0.f, 1.f}; if (mode) st2[s] = *(const PG8_GAS f32x2*)(stats + 2 * (size_t)(r0 + 8 * s + rrow)); }
#pragma unroll
                for (int bj = 0; bj < 2; ++bj) {
                    const size_t off0 = (size_t)(r0 + rrow) * 1024 + u.pn * BM + bj * HALF + wc * 32 + 4 * rch;
                    f32x4 xo[2];
#pragma unroll
                    for (int s = 0; s < 2; ++s) xo[s] = mode ? *(const PG8_GAS f32x4*)(Z + off0 + (size_t)s * 8192) : *(const PG8_GAS f32x4*)(xin + off0 + (size_t)s * 8192);
#pragma unroll
                    for (int n = 0; n < 2; ++n) *(PG8_LAS f32x4*)(sw + wrow + (((4 * n + fq) ^ (fr & 7)) << 4)) = acc[ai][bj][m][n];
                    asm volatile("s_waitcnt lgkmcnt(0)" ::: "memory");
                    f32x4 av[2];
#pragma unroll
                    for (int s = 0; s < 2; ++s) av[s] = *(const PG8_LAS f32x4*)(sw + (8 * s + rrow) * 128 + ((rch ^ ((8 * s + rrow) & 7)) << 4));
                    asm volatile("s_waitcnt lgkmcnt(0)" ::: "memory");
#pragma unroll
                    for (int s = 0; s < 2; ++s) {
                        f32x4 xv = xo[s];
                        if (mode) xv = (xv - st2[s].x) * st2[s].y * lg[bj] + lb[bj];
                        *(PG8_GAS f32x4*)(Z + off0 + (size_t)s * 8192) = xv * alpha + gt[bj] * av[s];
                    }
                }
            }
    }
};

__device__ __forceinline__ float gate_logf(float fp, float lb) {
    const float e = __expf(-fabsf(fp)), l1pe = __logf(1.f + e);
    return (fp >= 0.f ? __logf(1.f + lb * e) : (lb > 0.f ? __logf(lb + e) : fp)) - l1pe;
}
struct EpiMixIn {
    static constexpr bool PERM = true, AFTER_DRAIN = false;
    bf16_t* proj; const float* rope; const float* lbl;
    __device__ __forceinline__ void operator()(const f32x4 (&acc)[2][2][4][2], const Unit& u, int wr, int wc, int fr, int fq) const {
        const int seg = u.pn >> 1; const int rbase = u.pm * BM + wr * 64 + fr; const int b = u.pm >> 5;
        bf16_t* segp = proj + (size_t)seg * ((size_t)65536 * 512);
#pragma unroll
        for (int bj = 0; bj < 2; ++bj) {
            const int wcol = (u.pn & 1) * 256 + bj * HALF + wc * 32 + 8 * fq;
            if (seg < 3) {
                const int head = wcol >> 6, ch = wcol & 63;
                const bool rotw = (seg < 2) && ((wc & 1) == 0);
#pragma unroll
                for (int ai = 0; ai < 2; ++ai)
#pragma unroll
                    for (int m = 0; m < 4; ++m) {
                        const int r = rbase + ai * HALF + m * 16; const int s = r & 8191;
                        f32x4 v0 = acc[ai][bj][m][0], v1 = acc[ai][bj][m][1];
                        if (rotw) {
                            f32x4 p0, p1;
#pragma unroll
                            for (int j = 0; j < 4; ++j) { p0[j] = __shfl_xor(v0[j], 16); p1[j] = __shfl_xor(v1[j], 16); }
                            if (fq < 2) {
                                const f32x4 c0 = *(const PG8_GAS f32x4*)(rope + (size_t)r * 16), c1 = *(const PG8_GAS f32x4*)(rope + (size_t)r * 16 + 4);
                                const f32x4 s0 = *(const PG8_GAS f32x4*)(rope + (size_t)r * 16 + 8), s1 = *(const PG8_GAS f32x4*)(rope + (size_t)r * 16 + 12);
                                if (fq == 0) { v0 = v0 * c0 - p0 * s0; v1 = v1 * c1 - p1 * s1; }
                                else { v0 = v0 * c0 + p0 * s0; v1 = v1 * c1 + p1 * s1; }
                            }
                        }
                        if (seg == 0) { v0 = v0 * 0.18033688011112042f; v1 = v1 * 0.18033688011112042f; }
                        u32x4 w; w.x = cvt_pk_bf16(v0[0], v0[1]); w.y = cvt_pk_bf16(v0[2], v0[3]); w.z = cvt_pk_bf16(v1[0], v1[1]); w.w = cvt_pk_bf16(v1[2], v1[3]);
                        *(PG8_GAS u32x4*)(segp + ((size_t)((b * 8 + head) * 8192 + s)) * 64 + ch) = w;
                    }
            } else {
#pragma unroll
                for (int ai = 0; ai < 2; ++ai)
#pragma unroll
                    for (int m = 0; m < 4; ++m) {
                        const int r = rbase + ai * HALF + m * 16;
                        f32x4 v0 = acc[ai][bj][m][0], v1 = acc[ai][bj][m][1];
                        if (seg == 3 || seg == 6) {
#pragma unroll
                            for (int j = 0; j < 4; ++j) { v0[j] = silu_f(v0[j]); v1[j] = silu_f(v1[j]); }
                        }
                        if (seg == 4) {
                            const f32x4 l0 = *(const PG8_GAS f32x4*)(lbl + wcol), l1 = *(const PG8_GAS f32x4*)(lbl + wcol + 4);
#pragma unroll
                            for (int j = 0; j < 4; ++j) { v0[j] = gate_logf(v0[j], l0[j]); v1[j] = gate_logf(v1[j], l1[j]); }
                        }
                        u32x4 w;
                        if (seg == 4) { w.x = cvt_pk_f16(v0[0], v0[1]); w.y = cvt_pk_f16(v0[2], v0[3]); w.z = cvt_pk_f16(v1[0], v1[1]); w.w = cvt_pk_f16(v1[2], v1[3]); }
                        else { w.x = cvt_pk_bf16(v0[0], v0[1]); w.y = cvt_pk_bf16(v0[2], v0[3]); w.z = cvt_pk_bf16(v1[0], v1[1]); w.w = cvt_pk_bf16(v1[2], v1[3]); }
                        *(PG8_GAS u32x4*)(segp + (size_t)r * 512 + wcol) = w;
                    }
            }
        }
    }
};

template <class Epi, class Sched, bool ALIGN_EPI = false, bool SP2 = false>
__device__ __forceinline__ void gemm_phase(PG8_LAS unsigned char* lds, const Gemm g, const Sched& S, const Epi& E, const int tid) {
    const int wid = __builtin_amdgcn_readfirstlane(tid >> 6), lane = tid & 63, wr = wid >> 2, wc = wid & 3, fr = lane & 15, fq = lane >> 4;
    const int K = g.K, nt = K / BK;
    unsigned voffA[2], voffB[2];
#pragma unroll
    for (int i = 0; i < 2; ++i) { int R, C; stage_rc(tid * 16 + i * 8192, R, C); const int Rb = Epi::PERM ? ((R & ~31) + perm32(R & 31)) : R;
        voffA[i] = (unsigned)(R * K + C) * 2u; voffB[i] = (unsigned)(Rb * K + C) * 2u; }
    const size_t kstep = (size_t)(BK * 2);
    const size_t hstep = (size_t)HALF * K * 2;
    const size_t tstep = 2 * hstep;
    const unsigned ldsw = (unsigned)wid * 1024u;
    const int aoff = lds_byte(wr * 64 + fr, fq * 8), boff = lds_byte(wc * 32 + fr, fq * 8);
#define PG8_SA(b, h) (((b) * 2 + (h)) * HTB)
#define PG8_SB(b, h) ((4 + (b) * 2 + (h)) * HTB)
#define PG8_STAGE(bufoff, gbase, voff) do { _Pragma("unroll") for (int _i = 0; _i < 2; ++_i) \
        __builtin_amdgcn_global_load_lds((const unsigned*)((const char*)(gbase) + (voff)[_i]), (PG8_LAS unsigned*)(lds + (bufoff) + ldsw + _i * 8192), 16, 0, 0); } while (0)
#define PG8_LDA(dst, b, h) do { _Pragma("unroll") for (int m = 0; m < 4; ++m) _Pragma("unroll") for (int k = 0; k < 2; ++k) dst[m][k] = *(const PG8_LAS bf16x8*)(lds + PG8_SA(b, h) + aoff + m * 2048 + k * 1024); } while (0)
#define PG8_LDB(dst, b, h) do { _Pragma("unroll") for (int n = 0; n < 2; ++n) _Pragma("unroll") for (int k = 0; k < 2; ++k) dst[n][k] = *(const PG8_LAS bf16x8*)(lds + PG8_SB(b, h) + boff + n * 2048 + k * 1024); } while (0)
#define PG8_MMA(ai, bj, At, Bt) do { __builtin_amdgcn_s_setprio(1); _Pragma("unroll") for (int m = 0; m < 4; ++m) _Pragma("unroll") for (int n = 0; n < 2; ++n) _Pragma("unroll") for (int k = 0; k < 2; ++k) \
        acc[ai][bj][m][n] = __builtin_amdgcn_mfma_f32_16x16x32_bf16(Bt[n][k], At[m][k], acc[ai][bj][m][n], 0, 0, 0); __builtin_amdgcn_s_setprio(0); } while (0)
#define PG8_WAIT_V(n) asm volatile("s_waitcnt vmcnt(" #n ")" ::: "memory")
#define PG8_WAIT_L(n) asm volatile("s_waitcnt lgkmcnt(" #n ")" ::: "memory")
#define PG8_BAR __builtin_amdgcn_s_barrier()
#define PG8_SCHED __builtin_amdgcn_sched_barrier(0)
    Unit cur, nxt; int ui = 0;
    if (!S.next(0, cur)) return;
    f32x4 acc[2][2][4][2];
#pragma unroll
    for (int a = 0; a < 2; ++a)
#pragma unroll
        for (int b = 0; b < 2; ++b)
#pragma unroll
            for (int m = 0; m < 4; ++m)
#pragma unroll
                for (int n = 0; n < 2; ++n) acc[a][b][m][n] = (f32x4){0.f, 0.f, 0.f, 0.f};
    bf16x8 At[4][2], B0[2][2], B1[2][2];
    const char* cA = (const char*)g.A + (size_t)cur.pm * tstep; const char* cB = (const char*)g.Bt + (size_t)cur.pn * tstep;
    S.a_ready(cur);
    if constexpr (SP2) {
        PG8_STAGE(PG8_SB(0, 0), cB, voffB); PG8_STAGE(PG8_SB(0, 1), cB + hstep, voffB); PG8_STAGE(PG8_SA(0, 0), cA, voffA); PG8_STAGE(PG8_SA(0, 1), cA + hstep, voffA);
        if (wr == 1) PG8_BAR;
        PG8_WAIT_V(2); PG8_BAR;
        PG8_STAGE(PG8_SB(1, 0), cB + kstep, voffB); PG8_STAGE(PG8_SA(1, 0), cA + kstep, voffA); PG8_STAGE(PG8_SB(1, 1), cB + hstep + kstep, voffB);
        PG8_WAIT_V(6); PG8_BAR;
    } else {
        PG8_STAGE(PG8_SB(0, 0), cB, voffB); PG8_STAGE(PG8_SA(0, 0), cA, voffA); PG8_STAGE(PG8_SB(0, 1), cB + hstep, voffB); PG8_STAGE(PG8_SA(0, 1), cA + hstep, voffA);
        if (wr == 1) PG8_BAR;
        PG8_WAIT_V(4); PG8_BAR;
        PG8_STAGE(PG8_SB(1, 0), cB + kstep, voffB); PG8_STAGE(PG8_SA(1, 0), cA + kstep, voffA); PG8_STAGE(PG8_SB(1, 1), cB + hstep + kstep, voffB);
        PG8_WAIT_V(6); PG8_BAR;
    }
    for (;;) {
        const bool has_next = S.next(ui + 1, nxt);
        const char* nA = has_next ? (const char*)g.A + (size_t)nxt.pm * tstep : cA; const char* nB = has_next ? (const char*)g.Bt + (size_t)nxt.pn * tstep : cB;
        for (int t = 0; t < nt; t += 2) {
            const bool last = (t == nt - 2);
            const char* a1 = cA + (size_t)(t + 1) * kstep;
            const char* a2 = last ? nA : cA + (size_t)(t + 2) * kstep; const char* b2 = last ? nB : cB + (size_t)(t + 2) * kstep;
            const char* a3 = a2 + kstep; const char* b3 = b2 + kstep;
            if (last && has_next) S.a_ready(nxt);
            if constexpr (SP2) {
            PG8_LDB(B0, 0, 0); PG8_LDB(B1, 0, 1); PG8_SCHED; PG8_LDA(At, 0, 0); PG8_STAGE(PG8_SA(1, 1), a1 + hstep, voffA);
            PG8_WAIT_V(8); PG8_WAIT_L(0); PG8_BAR; PG8_MMA(0, 0, At, B0); PG8_MMA(0, 1, At, B1); PG8_BAR; PG8_SCHED;
            PG8_LDA(At, 0, 1); PG8_STAGE(PG8_SB(0, 0), b2, voffB); PG8_STAGE(PG8_SB(0, 1), b2 + hstep, voffB); PG8_STAGE(PG8_SA(0, 0), a2, voffA);
            PG8_WAIT_V(8); PG8_WAIT_L(0); PG8_BAR; PG8_MMA(1, 0, At, B0); PG8_MMA(1, 1, At, B1); PG8_BAR; PG8_SCHED;
            PG8_LDB(B0, 1, 0); PG8_LDB(B1, 1, 1); PG8_SCHED; PG8_LDA(At, 1, 0); PG8_STAGE(PG8_SA(0, 1), a2 + hstep, voffA);
            PG8_WAIT_V(8); PG8_WAIT_L(0); PG8_BAR; PG8_MMA(0, 0, At, B0); PG8_MMA(0, 1, At, B1); PG8_BAR; PG8_SCHED;
            PG8_LDA(At, 1, 1); PG8_STAGE(PG8_SB(1, 0), b3, voffB); PG8_STAGE(PG8_SB(1, 1), b3 + hstep, voffB); PG8_STAGE(PG8_SA(1, 0), a3, voffA);
            PG8_WAIT_V(8); PG8_WAIT_L(0); PG8_BAR; PG8_MMA(1, 0, At, B0); PG8_MMA(1, 1, At, B1); PG8_BAR; PG8_SCHED;
            } else {
            PG8_LDB(B0, 0, 0); PG8_SCHED; PG8_LDA(At, 0, 0); PG8_STAGE(PG8_SA(1, 1), a1 + hstep, voffA);
            PG8_WAIT_L(8); PG8_BAR; PG8_WAIT_L(0); PG8_MMA(0, 0, At, B0); PG8_BAR; PG8_SCHED;
            PG8_LDB(B1, 0, 1); PG8_STAGE(PG8_SB(0, 0), b2, voffB);
            PG8_BAR; PG8_WAIT_L(0); PG8_MMA(0, 1, At, B1); PG8_BAR;
            PG8_LDA(At, 0, 1); PG8_STAGE(PG8_SA(0, 0), a2, voffA);
            PG8_BAR; PG8_WAIT_L(0); PG8_MMA(1, 0, At, B0); PG8_BAR; PG8_SCHED;
            PG8_STAGE(PG8_SB(0, 1), b2 + hstep, voffB);
            PG8_WAIT_V(6); PG8_BAR; PG8_MMA(1, 1, At, B1); PG8_BAR;
            PG8_LDB(B0, 1, 0); PG8_SCHED; PG8_LDA(At, 1, 0); PG8_STAGE(PG8_SA(0, 1), a2 + hstep, voffA);
            PG8_WAIT_L(8); PG8_BAR; PG8_WAIT_L(0); PG8_MMA(0, 0, At, B0); PG8_BAR; PG8_SCHED;
            PG8_LDB(B1, 1, 1); PG8_STAGE(PG8_SB(1, 0), b3, voffB);
            PG8_BAR; PG8_WAIT_L(0); PG8_MMA(0, 1, At, B1); PG8_BAR;
            PG8_LDA(At, 1, 1); PG8_STAGE(PG8_SA(1, 0), a3, voffA);
            PG8_BAR; PG8_WAIT_L(0); PG8_MMA(1, 0, At, B0); PG8_BAR; PG8_SCHED;
            PG8_STAGE(PG8_SB(1, 1), b3 + hstep, voffB);
            PG8_WAIT_V(6); PG8_BAR; PG8_MMA(1, 1, At, B1); PG8_BAR;
            }
        }
        if constexpr (ALIGN_EPI) { if (wr == 0) PG8_BAR; }
        if constexpr (!Epi::AFTER_DRAIN) { E(acc, cur, wr, wc, fr, fq); S.done(cur); }
        if (!has_next) break;
#pragma unroll
        for (int a = 0; a < 2; ++a)
#pragma unroll
            for (int b = 0; b < 2; ++b)
#pragma unroll
                for (int m = 0; m < 4; ++m)
#pragma unroll
                    for (int n = 0; n < 2; ++n) acc[a][b][m][n] = (f32x4){0.f, 0.f, 0.f, 0.f};
        cur = nxt; cA = nA; cB = nB; ++ui;
        if constexpr (ALIGN_EPI) { if (wr == 1) PG8_BAR; }
    }
    PG8_WAIT_V(0);
    if constexpr (!ALIGN_EPI) { if (wr == 0) PG8_BAR; }
    PG8_BAR;
    if constexpr (Epi::AFTER_DRAIN) { E.fused(acc, cur, wr, wc, fr, fq, lds, wid, lane); S.done(cur); }
#undef PG8_SA
#undef PG8_SB
#undef PG8_STAGE
#undef PG8_LDA
#undef PG8_LDB
#undef PG8_MMA
#undef PG8_WAIT_V
#undef PG8_WAIT_L
#undef PG8_BAR
#undef PG8_SCHED
}
}

#define LAS __attribute__((address_space(3)))
typedef unsigned short bf16;
typedef unsigned v4u __attribute__((ext_vector_type(4)));
typedef unsigned v2u __attribute__((ext_vector_type(2)));
typedef float f32x4 __attribute__((ext_vector_type(4)));
typedef float f32x2v __attribute__((ext_vector_type(2)));
typedef float f32x16 __attribute__((ext_vector_type(16)));
typedef short bf16x8 __attribute__((ext_vector_type(8)));
typedef short s16x4 __attribute__((ext_vector_type(4)));
typedef short v4i16_t __attribute__((ext_vector_type(4)));

constexpr int NB = 8, SEQ = 8192, M = NB * SEQ, D = 1024, FF = 2816, NIN = 3584, NADA = 9216;
constexpr float LN_EPS = 1e-5f, RMS_EPS = 1e-6f, DN_ALPHA = 1.41421356237309515f;
constexpr size_t MiB = 1u << 20;
constexpr size_t WS_ADA = 0, WS_STATS = 1 * MiB, WS_LB = 1 * MiB + 512 * 1024, WS_ROPE = 2 * MiB, WS_HDEC = 6 * MiB, WS_ML = 8 * MiB;
constexpr size_t WS_W = 16 * MiB;
constexpr size_t W_LAYER = 42 * MiB, W_1IN = 0, W_1OUT = 11 * MiB, W_2IN = 11 * MiB + 5632 * 1024, W_2OUT = 22 * MiB + 5632 * 1024, W_MIN = 33 * MiB, W_MOUT = 40 * MiB;
constexpr size_t WS_H = 112 * MiB;
constexpr size_t WS_BIG = 240 * MiB;
constexpr size_t WS_DS = 688 * MiB;
constexpr size_t WS_OP = 816 * MiB;
constexpr size_t WS_END = 944 * MiB;
constexpr size_t SEG = (size_t)65536 * 512;
constexpr int LDS_BYTES = 147456;

__device__ __forceinline__ unsigned f2bf(float f) { unsigned u = __builtin_bit_cast(unsigned, f); return (u + 0x7fffu + ((u >> 16) & 1u)) >> 16; }
__device__ __forceinline__ unsigned pk2(float lo, float hi) { return pg8::cvt_pk_bf16(lo, hi); }
__device__ __forceinline__ float bf2f(unsigned short v) { return __builtin_bit_cast(float, (unsigned)v << 16); }
__device__ __forceinline__ float h2f(unsigned short v) { return (float)__builtin_bit_cast(_Float16, v); }
__device__ __forceinline__ float wave_sum(float v) {
#pragma unroll
    for (int o = 1; o < 64; o <<= 1) v += __shfl_xor(v, o);
    return v;
}
#define LDS_WAIT() asm volatile("s_waitcnt lgkmcnt(0)" ::: "memory")
#define GAS __attribute__((address_space(1)))
template <class T> __device__ __forceinline__ T gld(const void* p) { return *(const GAS T*)p; }
template <class T> __device__ __forceinline__ void gst(void* p, T v) { *(GAS T*)p = v; }

struct Args { const void* in[15]; float* out; unsigned char* ws; float invf[8]; int ph_lo, ph_hi; };

__device__ __forceinline__ void transpose_item(const float* W, int K, int N, bf16* WT, LAS float* scr, int item, int lane, bool swiglu) {
    const int nblk = N / 32, kb = item / nblk, nb = item % nblk, k0 = 64 * kb, n0 = 32 * nb;
    int sc0 = n0;
    if (swiglu) { const int pn = n0 >> 8, w = n0 & 255; sc0 = (w >> 7) * FF + pn * 128 + (w & 127); }
    float wv[32];
#pragma unroll
    for (int i = 0; i < 32; ++i) wv[i] = W[(size_t)(k0 + 2 * i + (lane >> 5)) * N + sc0 + (lane & 31)];
#pragma unroll
    for (int i = 0; i < 32; ++i) scr[(2 * i + (lane >> 5)) * 33 + (lane & 31)] = wv[i];
    LDS_WAIT();
    const int c = lane & 7;
#pragma unroll
    for (int j = 0; j < 4; ++j) { const int n = (lane >> 3) + 8 * j; const LAS float* s = scr + (8 * c) * 33 + n;
        v4u o; o.x = pk2(s[0 * 33], s[1 * 33]); o.y = pk2(s[2 * 33], s[3 * 33]); o.z = pk2(s[4 * 33], s[5 * 33]); o.w = pk2(s[6 * 33], s[7 * 33]);
        *(v4u*)(WT + (size_t)(n0 + n) * K + k0 + 8 * c) = o; }
    LDS_WAIT();
}

__device__ __forceinline__ void prologue_phase(const Args& a, LAS unsigned char* lds, int tid, int lane, int wave, int G) {
    unsigned char* ws = a.ws;
    const int gw = blockIdx.x * 8 + wave, NGW = G * 8;
    {
        LAS float* scr = (LAS float*)(lds + wave * 16384);
        constexpr int I_FI = 16 * 176, I_FO = 44 * 32, I_MI = 16 * 112, I_MO = 16 * 32, I_L = 2 * I_FI + 2 * I_FO + I_MI + I_MO;
        for (int it = gw; it < 2 * I_L; it += NGW) {
            const int l = it / I_L; int r = it % I_L;
            unsigned char* wl = ws + WS_W + (size_t)l * W_LAYER;
            if (r < I_FI) { transpose_item((const float*)a.in[7] + (size_t)l * D * 2 * FF, D, 2 * FF, (bf16*)(wl + W_1IN), scr, r, lane, true); continue; } r -= I_FI;
            if (r < I_FI) { transpose_item((const float*)a.in[9] + (size_t)l * D * 2 * FF, D, 2 * FF, (bf16*)(wl + W_2IN), scr, r, lane, true); continue; } r -= I_FI;
            if (r < I_FO) { transpose_item((const float*)a.in[8] + (size_t)l * FF * D, FF, D, (bf16*)(wl + W_1OUT), scr, r, lane, false); continue; } r -= I_FO;
            if (r < I_FO) { transpose_item((const float*)a.in[10] + (size_t)l * FF * D, FF, D, (bf16*)(wl + W_2OUT), scr, r, lane, false); continue; } r -= I_FO;
            if (r < I_MI) { transpose_item((const float*)a.in[11] + (size_t)l * D * NIN, D, NIN, (bf16*)(wl + W_MIN), scr, r, lane, false); continue; } r -= I_MI;
            transpose_item((const float*)a.in[12] + (size_t)l * D * D, D, D, (bf16*)(wl + W_MOUT), scr, r, lane, false);
        }
    }
    __syncthreads();
    {
        const float* cin = (const float*)a.in[1]; const float* aw = (const float*)a.in[5]; const float* ab = (const float*)a.in[6];
        float* ada = (float*)(ws + WS_ADA);
        LAS float* red = (LAS float*)lds;
        LAS float* cond = (LAS float*)(lds + 16384);
        for (int i = tid; i < 8 * D; i += 512) { const float cv = cin[i]; cond[i] = cv * __builtin_amdgcn_rcpf(1.f + __expf(-cv)); }
        __syncthreads();
        for (int it = blockIdx.x; it < 512; it += G) {
            const int l = it >> 8, n0 = (it & 255) * 36;
            float acc[8];
#pragma unroll
            for (int b = 0; b < 8; ++b) acc[b] = 0.f;
            if (lane < 36) {
                const float* wp = aw + ((size_t)l * D + wave * 128) * NADA + n0 + lane;
#pragma unroll 1
                for (int k0 = 0; k0 < 128; k0 += 32) {
                    float w[32];
#pragma unroll
                    for (int k = 0; k < 32; ++k) w[k] = wp[(size_t)(k0 + k) * NADA];
#pragma unroll
                    for (int k = 0; k < 32; ++k) {
#pragma unroll
                        for (int b = 0; b < 8; ++b) acc[b] += cond[b * D + wave * 128 + k0 + k] * w[k];
                    }
                }
#pragma unroll
                for (int b = 0; b < 8; ++b) red[(wave * 8 + b) * 36 + lane] = acc[b];
            }
            __syncthreads();
            if (tid < 288) { const int b = tid / 36, n = tid % 36; float s = ab[l * NADA + n0 + n];
#pragma unroll
                for (int w = 0; w < 8; ++w) s += red[(w * 8 + b) * 36 + n];
                ada[((size_t)l * 8 + b) * NADA + n0 + n] = s; }
            __syncthreads();
        }
    }
    {
        const float* lg = (const float*)a.in[14]; float* lbv = (float*)(ws + WS_LB);
        const int gt = blockIdx.x * 512 + tid;
        if (gt < 9) ((unsigned*)(ws + WS_LB + 8192))[64 * gt] = 0u;
        if (gt < 512) { const float l0 = lg[gt], l1 = lg[512 + gt]; lbv[gt] = 0.f; lbv[512 + gt] = 1.f / (1.f + __expf(l0 - l1)); }
    }
    {
        const int* pos = (const int*)a.in[2]; float* rope = (float*)(ws + WS_ROPE);
        for (int r = blockIdx.x * 512 + tid; r < M; r += G * 512) {
            const float pf = (float)pos[r];
            f32x4 cv[2], sv[2];
#pragma unroll
            for (int j = 0; j < 8; ++j) {
                const float ang = pf * a.invf[j];
                const double rev = (double)ang * 0.15915494309189535; const float fr = (float)(rev - floor(rev));
                cv[j >> 2][j & 3] = __builtin_amdgcn_cosf(fr); sv[j >> 2][j & 3] = __builtin_amdgcn_sinf(fr);
            }
            *(f32x4*)(rope + (size_t)r * 16) = cv[0]; *(f32x4*)(rope + (size_t)r * 16 + 4) = cv[1];
            *(f32x4*)(rope + (size_t)r * 16 + 8) = sv[0]; *(f32x4*)(rope + (size_t)r * 16 + 12) = sv[1];
        }
    }
}

template <int MODE>
__device__ __forceinline__ void lnmod_phase(const float* src, float* dst, float* stats, bf16* H, const float* lng, const float* lnb, const float* ada_mod  , int lane, int wave, int G) {
    const int gw = blockIdx.x * 8 + wave, NGW = G * 8;
    for (int chunk = gw; chunk < M / 32; chunk += NGW) {
        const int b = chunk >> 8;
        f32x4 g[4], bb[4], sc[4], sh[4];
#pragma unroll
        for (int j = 0; j < 4; ++j) {
            const int c = 4 * lane + 256 * j;
            if (MODE != 0) { g[j] = gld<f32x4>(lng + c); bb[j] = gld<f32x4>(lnb + c); }
            if (MODE != 2) { sh[j] = gld<f32x4>(ada_mod + (size_t)b * NADA + c); sc[j] = gld<f32x4>(ada_mod + (size_t)b * NADA + 1024 + c) + 1.f; }
        }
        f32x4 v[4], nx[4];
        const float* rp = src + (size_t)chunk * 32 * D + 4 * lane;
#pragma unroll
        for (int j = 0; j < 4; ++j) nx[j] = gld<f32x4>(rp + 256 * j);
        for (int i = 0; i < 32; ++i) {
            const int r = chunk * 32 + i;
#pragma unroll
            for (int j = 0; j < 4; ++j) v[j] = nx[j];
            if (i + 1 < 32) {
#pragma unroll
                for (int j = 0; j < 4; ++j) nx[j] = gld<f32x4>(rp + (size_t)(i + 1) * D + 256 * j);
            }
            if (MODE != 0) {
                float s = 0.f;
#pragma unroll
                for (int j = 0; j < 4; ++j) s += (v[j].x + v[j].y) + (v[j].z + v[j].w);
                const float mean = wave_sum(s) * (1.f / D); float s2 = 0.f;
#pragma unroll
                for (int j = 0; j < 4; ++j) { v[j] = v[j] - mean; s2 += (v[j].x * v[j].x + v[j].y * v[j].y) + (v[j].z * v[j].z + v[j].w * v[j].w); }
                const float rstd = 1.f / sqrtf(wave_sum(s2) * (1.f / D) + LN_EPS);
                if (MODE == 1 && lane == 0) gst<f32x2v>(stats + 2 * (size_t)r, (f32x2v){mean, rstd});
#pragma unroll
                for (int j = 0; j < 4; ++j) v[j] = v[j] * rstd * g[j] + bb[j];
            }
            if (MODE == 2) {
#pragma unroll
                for (int j = 0; j < 4; ++j) gst<f32x4>(dst + (size_t)r * D + 4 * lane + 256 * j, v[j]);
            } else {
#pragma unroll
                for (int j = 0; j < 4; ++j) { const f32x4 hv = v[j] * sc[j] + sh[j]; v2u o; o.x = pk2(hv.x, hv.y); o.y = pk2(hv.z, hv.w);
                    gst<v2u>(H + (size_t)r * D + 4 * lane + 256 * j, o); }
            }
        }
    }
}

__device__ __forceinline__ int crow16(int i, int h) { return (i & 3) + 8 * (i >> 2) + 4 * h; }
__device__ __forceinline__ s16x4 vtr(LAS const unsigned char* p) { return __builtin_bit_cast(s16x4, __builtin_amdgcn_ds_read_tr16_b64_v4i16((LAS v4i16_t*)p)); }
constexpr int VP = 128;

struct AttJob { int pos0, d, brmode, bar_after, b, head; size_t hb; };
__device__ __forceinline__ bool att_params(int q, int nun, int G, int wave, AttJob& P) {
    const int ui = q / 6, r = q - 6 * ui, br = r >> 1, jj = r & 1;
    if (ui >= nun) return false;
    int uid;
    if (G == 256) { const int x = blockIdx.x & 7, sl = blockIdx.x >> 3; uid = ((x * 8 + (sl >> 2)) << 3) + (sl & 3) * 2 + ui; }
    else { uid = blockIdx.x + ui * G; if (uid >= 512) return false; }
    const int bh = uid >> 3, T0 = (uid & 7) * 1024;
    const int d = br == 0 ? 16 : (br == 1 ? 4 : 1), pj = wave + 8 * jj;
    const int p0 = d == 1 ? 64 * pj : (d == 4 ? 256 * (pj & 3) + (pj >> 2) : pj);
    P.pos0 = T0 + p0; P.d = d; P.brmode = br; P.bar_after = (jj == 1 && br < 2) ? 1 : 0; P.b = bh >> 3; P.head = bh & 7; P.hb = (size_t)bh * SEQ;
    return true;
}
__device__ __forceinline__ void att_block(const bf16x8 (&kf)[4], const bf16x8 (&qf)[4], const bf16x8 (&va)[4], f32x16& o0, f32x16& o1, float& mrun, float& lrun, bool domask, int lo_, int hi_) {
    f32x16 st;
#pragma unroll
    for (int i = 0; i < 16; ++i) st[i] = 0.f;
#pragma unroll
    for (int kk = 0; kk < 4; ++kk) st = __builtin_amdgcn_mfma_f32_32x32x16_bf16(kf[kk], qf[kk], st, 0, 0, 0);
    if (domask) {
        asm volatile("" : "+v"(lo_), "+v"(hi_));
#pragma unroll
        for (int i = 0; i < 16; ++i) { const int ci = (i & 3) + 8 * (i >> 2); st[i] = ((ci - lo_) | (hi_ - ci)) < 0 ? -INFINITY : st[i]; }
    }
    float bmax = -INFINITY;
#pragma unroll
    for (int i = 0; i < 16; ++i) bmax = fmaxf(bmax, st[i]);
    bmax = fmaxf(bmax, __shfl_xor(bmax, 32));
    const float mnew = fmaxf(mrun, bmax);
    float lsum = 0.f;
#pragma unroll
    for (int i = 0; i < 16; ++i) { st[i] = __builtin_amdgcn_exp2f(st[i] - mnew); lsum += st[i]; }
    lsum += __shfl_xor(lsum, 32);
    const float alpha = __builtin_amdgcn_exp2f(mrun - mnew);
    lrun = lrun * alpha + lsum; mrun = mnew;
#pragma unroll
    for (int i = 0; i < 16; ++i) { o0[i] *= alpha; o1[i] *= alpha; }
#pragma unroll
    for (int s = 0; s < 2; ++s) { v4u w; w.x = pk2(st[8 * s], st[8 * s + 1]); w.y = pk2(st[8 * s + 2], st[8 * s + 3]); w.z = pk2(st[8 * s + 4], st[8 * s + 5]); w.w = pk2(st[8 * s + 6], st[8 * s + 7]);
        const bf16x8 pb = __builtin_bit_cast(bf16x8, w);
        o0 = __builtin_amdgcn_mfma_f32_32x32x16_bf16(va[2 * s], pb, o0, 0, 0, 0);
        o1 = __builtin_amdgcn_mfma_f32_32x32x16_bf16(va[2 * s + 1], pb, o1, 0, 0, 0); }
}
__device__ __forceinline__ void att_merge(f32x16& o0, f32x16& o1, float mrun, float lrun, int qpos, int brmode, bf16* OPh, float* MLh, bf16* outp, int h) {
    bf16* op = OPh + (size_t)qpos * 64 + 8 * h;
    if (brmode != 0) {
        const f32x2v mlp = gld<f32x2v>(MLh + 2 * (size_t)qpos);
        v4u pv[4];
#pragma unroll
        for (int g = 0; g < 4; ++g) pv[g] = gld<v4u>(op + 16 * g);
        const float mnew = fmaxf(mrun, mlp.x), ao = __builtin_amdgcn_exp2f(mlp.x - mnew), an = __builtin_amdgcn_exp2f(mrun - mnew);
        lrun = lrun * an + mlp.y * ao; mrun = mnew;
#pragma unroll
        for (int g = 0; g < 4; ++g) {
            const auto rx = __builtin_amdgcn_permlane32_swap(pv[g].x, pv[g].z, false, false);
            const auto ry = __builtin_amdgcn_permlane32_swap(pv[g].y, pv[g].w, false, false);
            const unsigned wa[2] = {rx[0], ry[0]}, wb[2] = {rx[1], ry[1]};
#pragma unroll
            for (int j = 0; j < 2; ++j) {
                const float a0 = __builtin_bit_cast(float, wa[j] << 16), a1 = __builtin_bit_cast(float, wa[j] & 0xffff0000u);
                const float b0 = __builtin_bit_cast(float, wb[j] << 16), b1 = __builtin_bit_cast(float, wb[j] & 0xffff0000u);
                if (g < 2) { o0[8 * g + 2 * j] = o0[8 * g + 2 * j] * an + a0 * ao; o0[8 * g + 2 * j + 1] = o0[8 * g + 2 * j + 1] * an + a1 * ao;
                             o0[8 * g + 4 + 2 * j] = o0[8 * g + 4 + 2 * j] * an + b0 * ao; o0[8 * g + 4 + 2 * j + 1] = o0[8 * g + 4 + 2 * j + 1] * an + b1 * ao; }
                else { const int e = 8 * (g - 2);
                       o1[e + 2 * j] = o1[e + 2 * j] * an + a0 * ao; o1[e + 2 * j + 1] = o1[e + 2 * j + 1] * an + a1 * ao;
                       o1[e + 4 + 2 * j] = o1[e + 4 + 2 * j] * an + b0 * ao; o1[e + 4 + 2 * j + 1] = o1[e + 4 + 2 * j + 1] * an + b1 * ao; }
            }
        }
    }
    float sc = 1.f; bf16* dst = op;
    if (brmode != 2) { if (h == 0) gst<f32x2v>(MLh + 2 * (size_t)qpos, (f32x2v){mrun, lrun}); }
    else { sc = 1.f / lrun; dst = outp + (size_t)qpos * 1024 + 8 * h; }
#pragma unroll
    for (int g = 0; g < 4; ++g) {
        unsigned ax, ay, bx, by;
        if (g < 2) { ax = pk2(o0[8 * g] * sc, o0[8 * g + 1] * sc); ay = pk2(o0[8 * g + 2] * sc, o0[8 * g + 3] * sc); bx = pk2(o0[8 * g + 4] * sc, o0[8 * g + 5] * sc); by = pk2(o0[8 * g + 6] * sc, o0[8 * g + 7] * sc); }
        else { const int e = 8 * (g - 2); ax = pk2(o1[e] * sc, o1[e + 1] * sc); ay = pk2(o1[e + 2] * sc, o1[e + 3] * sc); bx = pk2(o1[e + 4] * sc, o1[e + 5] * sc); by = pk2(o1[e + 6] * sc, o1[e + 7] * sc); }
        const auto rx = __builtin_amdgcn_permlane32_swap(ax, bx, false, false);
        const auto ry = __builtin_amdgcn_permlane32_swap(ay, by, false, false);
        gst<v4u>(dst + 16 * g, (v4u){rx[0], ry[0], rx[1], ry[1]});
    }
}

__device__ __forceinline__ void att_phase(unsigned char* ws, LAS unsigned char* lds, int lane, int wave, int G) {
    const bf16* Qa = (const bf16*)(ws + WS_BIG); const bf16* Ka = Qa + SEG; const bf16* Va = Qa + 2 * SEG;
    float* OP = (float*)(ws + WS_OP); float* ML = (float*)(ws + WS_ML); bf16* MO = (bf16*)(ws + WS_H);
    LAS unsigned char* vlds = lds + wave * 16384;
    const int nun = G == 256 ? 2 : (512 + G - 1) / G;
    const int qc = lane & 31, h = lane >> 5;
    const int i16 = lane & 15, tq = i16 >> 2, tp = i16 & 3, blk = (lane >> 4) & 1;
    LAS const unsigned char* trb = vlds + (4 * h + tq) * VP + (16 * blk) * 2 + 8 * tp;
    bf16x8 qfA[4], qfB[4];
#define ATT_DMA_KV(J, kb, slot) do { _Pragma("unroll") for (int i_ = 0; i_ < 4; ++i_) { const int key_ = 8 * i_ + (lane >> 3); int kp_ = (J).pos0 + (32 * (kb) + key_ - 128) * (J).d; kp_ = kp_ < 0 ? 0 : kp_; \
        __builtin_amdgcn_global_load_lds((const GAS unsigned*)(Ka + ((J).hb + (size_t)kp_) * 64 + (((lane & 7) ^ ((lane >> 3) & 7)) * 8)), (LAS unsigned*)(vlds + (slot) * 4096 + i_ * 1024), 16, 0, 0); \
        __builtin_amdgcn_global_load_lds((const GAS unsigned*)(Va + ((J).hb + (size_t)kp_) * 64 + (lane & 7) * 8), (LAS unsigned*)(vlds + 8192 + (slot) * 4096 + i_ * 1024), 16, 0, 0); } } while (0)
#define ATT_LOAD_Q(dst, J, set) do { const int qp_ = (J).pos0 + (32 * (set) + qc) * (J).d; _Pragma("unroll") for (int kk_ = 0; kk_ < 4; ++kk_) dst[kk_] = gld<bf16x8>(Qa + ((J).hb + (size_t)qp_) * 64 + 8 * h + 16 * kk_); } while (0)
    LAS const unsigned char* kfb = vlds + qc * 128;
    AttJob P, N;
    bool have = att_params(0, nun, G, wave, P);
    int sb = 0;
    if (have) { ATT_DMA_KV(P, 0, 0); ATT_LOAD_Q(qfA, P, 0); ATT_LOAD_Q(qfB, P, 1); }
#pragma unroll 1
    for (int q = 0; have; ++q) {
        const bool hn = att_params(q + 1, nun, G, wave, N);
        const int pos0 = P.pos0, d = P.d, brmode = P.brmode;
        bf16* OPh = (bf16*)OP + P.hb * 64; float* MLh = ML + P.hb * 2; bf16* outp = MO + (size_t)P.b * SEQ * 1024 + P.head * 64;
        float mA = -1e30f, lA = 0.f, mB = -1e30f, lB = 0.f;
        f32x16 oA0, oA1, oB0, oB1;
#pragma unroll
        for (int i = 0; i < 16; ++i) { oA0[i] = 0.f; oA1[i] = 0.f; oB0[i] = 0.f; oB1[i] = 0.f; }
        int kminA = 0, kminB = 0;
        { const int t0 = 128 * d - pos0; if (t0 > 0) kminA = (t0 + d - 1) / d; const int t1 = 96 * d - pos0; if (t1 > 0) kminB = (t1 + d - 1) / d; }
        const int mloA = qc > kminA ? qc : kminA, mloB = qc > kminB ? qc : kminB;
#pragma unroll
        for (int kb = 0; kb < 6; ++kb) {
            asm volatile("s_waitcnt vmcnt(0)" ::: "memory");
            if (kb < 5) ATT_DMA_KV(P, kb + 1, sb ^ 1);
            else if (hn) ATT_DMA_KV(N, 0, sb ^ 1);
            bf16x8 kf[4], va[4];
#pragma unroll
            for (int kk = 0; kk < 4; ++kk) kf[kk] = *(LAS const bf16x8*)(kfb + sb * 4096 + (((2 * kk + h) ^ (qc & 7)) << 4));
            LAS const unsigned char* trs = trb + 8192 + sb * 4096;
#pragma unroll
            for (int s = 0; s < 2; ++s) {
                const s16x4 lo0 = vtr(trs + (16 * s) * VP), hi0 = vtr(trs + (16 * s + 8) * VP);
                const s16x4 lo1 = vtr(trs + (16 * s) * VP + 64), hi1 = vtr(trs + (16 * s + 8) * VP + 64);
                va[2 * s] = (bf16x8){lo0[0], lo0[1], lo0[2], lo0[3], hi0[0], hi0[1], hi0[2], hi0[3]};
                va[2 * s + 1] = (bf16x8){lo1[0], lo1[1], lo1[2], lo1[3], hi1[0], hi1[1], hi1[2], hi1[3]};
            }
            if (kb <= 4) {
                att_block(kf, qfA, va, oA0, oA1, mA, lA, kb == 0 || kb == 4 || kminA > 32 * kb, mloA - 4 * h - 32 * kb, qc + 128 - 4 * h - 32 * kb);
                if (kb == 4 && hn) ATT_LOAD_Q(qfA, N, 0);
            }
            if (kb >= 1) {
                att_block(kf, qfB, va, oB0, oB1, mB, lB, kb == 1 || kb == 5 || kminB > 32 * (kb - 1), mloB - 4 * h - 32 * (kb - 1), qc + 128 - 4 * h - 32 * (kb - 1));
                if (kb == 5 && hn) ATT_LOAD_Q(qfB, N, 1);
            }
            LDS_WAIT();
            sb ^= 1;
            __builtin_amdgcn_sched_barrier(0);
        }
        att_merge(oA0, oA1, mA, lA, pos0 + qc * d, brmode, OPh, MLh, outp, h);
        att_merge(oB0, oB1, mB, lB, pos0 + (32 + qc) * d, brmode, OPh, MLh, outp, h);
        if (P.bar_after) { asm volatile("s_waitcnt vmcnt(0) lgkmcnt(0)" ::: "memory"); __syncthreads(); __builtin_amdgcn_fence(__ATOMIC_ACQUIRE, "agent"); }
        P = N; have = hn;
    }
#undef ATT_DMA_KV
#undef ATT_LOAD_Q
}

constexpr int RAWP = 272, KTP = 144;
__device__ __forceinline__ void hg_fetch(const bf16* src, int tok0, int hh, int tid, v4u (&r)[2]) {
#pragma unroll
    for (int i = 0; i < 2; ++i) { const int idx = tid + 512 * i, row = idx >> 4, ch = idx & 15;
        r[i] = gld<v4u>(src + (size_t)(tok0 + row) * 512 + hh * 128 + ch * 8); }
}
__device__ __forceinline__ void hg_put(const v4u (&r)[2], LAS unsigned char* dst, int tid) {
#pragma unroll
    for (int i = 0; i < 2; ++i) { const int idx = tid + 512 * i, row = idx >> 4, ch = idx & 15; *(LAS v4u*)(dst + row * RAWP + ch * 16) = r[i]; }
}
__device__ __forceinline__ void hg_job(int job, int& hh, int& tok0) { const int bh = job >> 7, ch = job & 127; hh = bh & 3; tok0 = (bh >> 2) * SEQ + ch * 64; }
__device__ __forceinline__ void hg_decay(LAS const unsigned char* rawF, LAS float* part, float lbc, int c, int j, float (&bc)[16], float (&kv)[16], float& tot, float& bref) {
    float run = 0.f;
#pragma unroll
    for (int i = 0; i < 16; ++i) { const float lf = h2f(*(LAS const unsigned short*)(rawF + (16 * j + i) * RAWP + 2 * c)); kv[i] = 1.f - __expf(lf); run += lf; bc[i] = run; }
    part[j * 128 + c] = run;
    __syncthreads();
    const float p0 = part[c], p1 = part[128 + c], p2 = part[256 + c], p3 = part[384 + c];
    const float pre = j == 0 ? 0.f : (j == 1 ? p0 : (j == 2 ? p0 + p1 : p0 + p1 + p2));
#pragma unroll
    for (int i = 0; i < 16; ++i) bc[i] += pre;
    tot = (p0 + p1) + (p2 + p3); bref = p0 + p1;
}
__device__ __forceinline__ void st16bf(LAS unsigned char* p, const float (&v)[16]) {
    v4u a, b; a.x = pk2(v[0], v[1]); a.y = pk2(v[2], v[3]); a.z = pk2(v[4], v[5]); a.w = pk2(v[6], v[7]);
    b.x = pk2(v[8], v[9]); b.y = pk2(v[10], v[11]); b.z = pk2(v[12], v[13]); b.w = pk2(v[14], v[15]);
    *(LAS v4u*)p = a; *(LAS v4u*)(p + 16) = b;
}

__device__ __forceinline__ void hgrn1_phase(unsigned char* ws, const float* lbl, LAS unsigned char* lds, int tid, int lane, int wave, int G) {
    const bf16* HF = (const bf16*)(ws + WS_BIG) + 4 * SEG; const bf16* HI = (const bf16*)(ws + WS_BIG) + 5 * SEG;
    bf16* DS = (bf16*)(ws + WS_DS); float* HDEC = (float*)(ws + WS_HDEC);
    LAS unsigned char* rawF = lds; LAS unsigned char* rawI = lds + 17408; LAS unsigned char* KT = lds + 34816; LAS unsigned char* VT = KT + 18432; LAS float* part = (LAS float*)(VT + 18432);
    const int c = tid & 127, j = tid >> 7, fr = lane & 15, fq = lane >> 4;
    v4u rF[2], rI[2];
    { int hh0, t0; hg_job(blockIdx.x, hh0, t0); if ((int)blockIdx.x < 4096) { hg_fetch(HF, t0, hh0, tid, rF); hg_fetch(HI, t0, hh0, tid, rI); } }
    for (int job = blockIdx.x; job < 4096; job += G) {
        int hh, tok0; hg_job(job, hh, tok0);
        hg_put(rF, rawF, tid); hg_put(rI, rawI, tid);
        __syncthreads();
        if (job + G < 4096) { int hn, tn; hg_job(job + G, hn, tn); hg_fetch(HF, tn, hn, tid, rF); hg_fetch(HI, tn, hn, tid, rI); }
        float bc[16], kv[16], tot, bref;
        hg_decay(rawF, part, lbl[hh * 128 + c], c, j, bc, kv, tot, bref);
        float tmp[16];
#pragma unroll
        for (int i = 0; i < 16; ++i) tmp[i] = kv[i] * __expf(tot - bc[i]);
        st16bf(KT + c * KTP + j * 32, tmp);
#pragma unroll
        for (int i = 0; i < 16; ++i) tmp[i] = bf2f(*(LAS const unsigned short*)(rawI + (16 * j + i) * RAWP + 2 * c));
        st16bf(VT + c * KTP + j * 32, tmp);
        if (j == 0) gst<float>(HDEC + (size_t)job * 128 + c, __expf(tot));
        __syncthreads();
        bf16x8 af[2];
#pragma unroll
        for (int kk = 0; kk < 2; ++kk) af[kk] = *(LAS const bf16x8*)(KT + (16 * wave + fr) * KTP + (8 * fq + 32 * kk) * 2);
#pragma unroll
        for (int n = 0; n < 8; ++n) {
            f32x4 cacc = (f32x4){0.f, 0.f, 0.f, 0.f};
#pragma unroll
            for (int kk = 0; kk < 2; ++kk) { const bf16x8 bfr = *(LAS const bf16x8*)(VT + (16 * n + fr) * KTP + (8 * fq + 32 * kk) * 2);
                cacc = __builtin_amdgcn_mfma_f32_16x16x32_bf16(af[kk], bfr, cacc, 0, 0, 0); }
            v2u w; w.x = pk2(cacc[0], cacc[1]); w.y = pk2(cacc[2], cacc[3]);
            gst<v2u>(DS + (size_t)job * 16384 + (n * 4 + (wave >> 1)) * 512 + (fr + 16 * (2 * (wave & 1) + (fq >> 1))) * 8 + 4 * (fq & 1), w);
        }
        __syncthreads();
    }
}

__device__ __forceinline__ void hgrn2_phase(unsigned char* ws, int tid, int G) {
    bf16* DS = (bf16*)(ws + WS_DS); const float* HDEC = (const float*)(ws + WS_HDEC);
    for (int gt = blockIdx.x * 512 + tid; gt < 32 * 4096; gt += G * 512) {
        const int bh = gt >> 12, e4 = gt & 4095; const int lin = 4 * e4, dk = 32 * ((lin >> 9) & 3) + 8 * (((lin & 511) >> 3) >> 4) + (lin & 7);
        bf16* p = DS + (size_t)bh * 128 * 16384 + 4 * e4; const float* dp = HDEC + (size_t)bh * 128 * 128 + dk;
        f32x4 s = (f32x4){0.f, 0.f, 0.f, 0.f};
#pragma unroll 1
        for (int c0 = 0; c0 < 128; c0 += 16) {
            v2u w[16]; f32x4 dc[16];
#pragma unroll
            for (int i = 0; i < 16; ++i) { w[i] = gld<v2u>(p + (size_t)(c0 + i) * 16384); dc[i] = gld<f32x4>(dp + (c0 + i) * 128); }
#pragma unroll
            for (int i = 0; i < 16; ++i) {
                v2u o; o.x = pk2(s.x, s.y); o.y = pk2(s.z, s.w); gst<v2u>(p + (size_t)(c0 + i) * 16384, o);
                const f32x4 dv = (f32x4){__builtin_bit_cast(float, w[i].x << 16), __builtin_bit_cast(float, w[i].x & 0xffff0000u), __builtin_bit_cast(float, w[i].y << 16), __builtin_bit_cast(float, w[i].y & 0xffff0000u)};
                s = dc[i] * s + dv;
            }
        }
    }
}

__device__ __forceinline__ void hgrn3_phase(unsigned char* ws, const float* lbl, const float* nw, LAS unsigned char* lds, int tid, int lane, int wave, int G) {
    const bf16* HQ = (const bf16*)(ws + WS_BIG) + 3 * SEG; const bf16* HF = HQ + SEG; const bf16* HI = HQ + 2 * SEG; const bf16* HG = HQ + 3 * SEG;
    const bf16* DS = (const bf16*)(ws + WS_DS); bf16* MO = (bf16*)(ws + WS_H);
    LAS unsigned char* rawQ = lds; LAS unsigned char* rawF = lds + 17408; LAS unsigned char* rawI = lds + 2 * 17408;
    LAS unsigned char* QT = lds + 3 * 17408; LAS unsigned char* KT = QT + 17408; LAS unsigned char* QH = KT + 17408;
    LAS unsigned char* VT = QH + 17408;
    LAS unsigned char* PT = VT + 18432;
    LAS float* part = (LAS float*)(PT + 9216);
    LAS float* ssq = part + 512;
    const int c = tid & 127, j = tid >> 7, fr = lane & 15, fq = lane >> 4;
    const int tt = wave >> 1, wh = wave & 1;
    v4u rQ[2], rF[2], rI[2];
    { int hh0, t0; hg_job(blockIdx.x, hh0, t0); if ((int)blockIdx.x < 4096) { hg_fetch(HQ, t0, hh0, tid, rQ); hg_fetch(HF, t0, hh0, tid, rF); hg_fetch(HI, t0, hh0, tid, rI); } }
    for (int job = blockIdx.x; job < 4096; job += G) {
        int hh, tok0; hg_job(job, hh, tok0);
        hg_put(rQ, rawQ, tid); hg_put(rF, rawF, tid); hg_put(rI, rawI, tid);
        bf16x8 sf[4][4];
#pragma unroll
        for (int n = 0; n < 4; ++n)
#pragma unroll
            for (int kk = 0; kk < 4; ++kk) sf[n][kk] = gld<bf16x8>(DS + (size_t)job * 16384 + ((4 * wh + n) * 4 + kk) * 512 + lane * 8);
        __syncthreads();
        if (job + G < 4096) { int hn, tn; hg_job(job + G, hn, tn); hg_fetch(HQ, tn, hn, tid, rQ); hg_fetch(HF, tn, hn, tid, rF); hg_fetch(HI, tn, hn, tid, rI); }
        {
            float bc[16], kv[16], tot, bref;
            hg_decay(rawF, part, lbl[hh * 128 + c], c, j, bc, kv, tot, bref);
#pragma unroll
            for (int i = 0; i < 16; ++i) {
                const int t = 16 * j + i;
                const float q = bf2f(*(LAS const unsigned short*)(rawQ + t * RAWP + 2 * c));
                const float dq = fminf(fmaxf(bc[i] - bref, -80.f), 80.f);
                *(LAS unsigned short*)(QT + t * RAWP + 2 * c) = (unsigned short)pk2(q * __expf(dq), 0.f);
                *(LAS unsigned short*)(KT + t * RAWP + 2 * c) = (unsigned short)pk2(kv[i] * __expf(-dq), 0.f);
                *(LAS unsigned short*)(QH + t * RAWP + 2 * c) = (unsigned short)pk2(q * __expf(bc[i]), 0.f);
            }
            float tmp[16];
#pragma unroll
            for (int i = 0; i < 16; ++i) tmp[i] = bf2f(*(LAS const unsigned short*)(rawI + (16 * j + i) * RAWP + 2 * c));
            st16bf(VT + c * KTP + j * 32, tmp);
        }
        __syncthreads();
        {
            bf16x8 qfr[4];
#pragma unroll
            for (int kk = 0; kk < 4; ++kk) qfr[kk] = *(LAS const bf16x8*)(QT + (16 * tt + fr) * RAWP + (8 * fq + 32 * kk) * 2);
#pragma unroll
            for (int si = 0; si < 2; ++si) {
                const int stile = 2 * wh + si;
                f32x4 cacc = (f32x4){0.f, 0.f, 0.f, 0.f};
#pragma unroll
                for (int kk = 0; kk < 4; ++kk) { const bf16x8 kfr = *(LAS const bf16x8*)(KT + (16 * stile + fr) * RAWP + (8 * fq + 32 * kk) * 2);
                    cacc = __builtin_amdgcn_mfma_f32_16x16x32_bf16(kfr, qfr[kk], cacc, 0, 0, 0); }
                const int t = 16 * tt + fr, s0 = 16 * stile + 4 * fq;
#pragma unroll
                for (int i = 0; i < 4; ++i) cacc[i] = (s0 + i <= t) ? cacc[i] : 0.f;
                v2u w; w.x = pk2(cacc[0], cacc[1]); w.y = pk2(cacc[2], cacc[3]);
                *(LAS v2u*)(PT + t * KTP + s0 * 2) = w;
            }
        }
        __syncthreads();
        v2u gpre[4];
#pragma unroll
        for (int n = 0; n < 4; ++n) gpre[n] = gld<v2u>(HG + (size_t)(tok0 + 16 * tt + fr) * 512 + hh * 128 + 16 * (4 * wh + n) + 4 * fq);
        f32x4 oacc[4];
        {
            bf16x8 pfr[2], qh[4];
#pragma unroll
            for (int kk = 0; kk < 2; ++kk) pfr[kk] = *(LAS const bf16x8*)(PT + (16 * tt + fr) * KTP + (8 * fq + 32 * kk) * 2);
#pragma unroll
            for (int kk = 0; kk < 4; ++kk) qh[kk] = *(LAS const bf16x8*)(QH + (16 * tt + fr) * RAWP + (8 * fq + 32 * kk) * 2);
#pragma unroll
            for (int n = 0; n < 4; ++n) {
                f32x4 cacc = (f32x4){0.f, 0.f, 0.f, 0.f};
#pragma unroll
                for (int kk = 0; kk < 2; ++kk) { const bf16x8 vfr = *(LAS const bf16x8*)(VT + (16 * (4 * wh + n) + fr) * KTP + (8 * fq + 32 * kk) * 2);
                    cacc = __builtin_amdgcn_mfma_f32_16x16x32_bf16(vfr, pfr[kk], cacc, 0, 0, 0); }
#pragma unroll
                for (int kk = 0; kk < 4; ++kk) cacc = __builtin_amdgcn_mfma_f32_16x16x32_bf16(sf[n][kk], qh[kk], cacc, 0, 0, 0);
                oacc[n] = cacc;
            }
        }
        float sq = 0.f;
#pragma unroll
        for (int n = 0; n < 4; ++n) sq += (oacc[n][0] * oacc[n][0] + oacc[n][1] * oacc[n][1]) + (oacc[n][2] * oacc[n][2] + oacc[n][3] * oacc[n][3]);
        sq += __shfl_xor(sq, 16); sq += __shfl_xor(sq, 32);
        if (fq == 0) ssq[wh * 64 + 16 * tt + fr] = sq;
        __syncthreads();
        {
            const int t = 16 * tt + fr;
            const float rinv = 1.f / sqrtf((ssq[t] + ssq[64 + t]) * (1.f / 128.f) + RMS_EPS);
#pragma unroll
            for (int n = 0; n < 4; ++n) {
                const int dv = 16 * (4 * wh + n) + 4 * fq;
                const f32x4 nwv = gld<f32x4>(nw + hh * 128 + dv);
                const v2u gw_ = gpre[n];
                const f32x4 gv = (f32x4){__builtin_bit_cast(float, gw_.x << 16), __builtin_bit_cast(float, gw_.x & 0xffff0000u), __builtin_bit_cast(float, gw_.y << 16), __builtin_bit_cast(float, gw_.y & 0xffff0000u)};
                const f32x4 ov = oacc[n] * rinv * nwv * gv;
                v2u w; w.x = pk2(ov[0], ov[1]); w.y = pk2(ov[2], ov[3]);
                gst<v2u>(MO + (size_t)(tok0 + t) * 1024 + 512 + hh * 128 + dv, w);
            }
        }
        __syncthreads();
    }
}

__device__ __forceinline__ void grid_bar(unsigned* ctrs, unsigned gen, int tid, unsigned G) {
    asm volatile("s_waitcnt vmcnt(0) lgkmcnt(0)" ::: "memory");
    __syncthreads();
    if (tid == 0) {
        __builtin_amdgcn_fence(__ATOMIC_RELEASE, "agent");
        if ((G & 7u) == 0u) {
            const unsigned g = blockIdx.x & 7u, gs = G >> 3;
            const unsigned old = __hip_atomic_fetch_add(ctrs + 64 * (1 + g), 1u, __ATOMIC_RELAXED, __HIP_MEMORY_SCOPE_AGENT);
            if (old + 1u == gen * gs) __hip_atomic_fetch_add(ctrs, 1u, __ATOMIC_RELAXED, __HIP_MEMORY_SCOPE_AGENT);
            while (__hip_atomic_load(ctrs, __ATOMIC_RELAXED, __HIP_MEMORY_SCOPE_AGENT) < gen * 8u) __builtin_amdgcn_s_sleep(1);
        } else {
            __hip_atomic_fetch_add(ctrs, 1u, __ATOMIC_RELAXED, __HIP_MEMORY_SCOPE_AGENT);
            while (__hip_atomic_load(ctrs, __ATOMIC_RELAXED, __HIP_MEMORY_SCOPE_AGENT) < gen * G) __builtin_amdgcn_s_sleep(1);
        }
        __builtin_amdgcn_fence(__ATOMIC_ACQUIRE, "agent");
    }
    __syncthreads();
}
constexpr int N_PHASES = 26;
__global__ void __launch_bounds__(512, 2) mk_fwd(Args a) {
    extern __shared__ __attribute__((aligned(16))) unsigned char lds_raw[];
    LAS unsigned char* lds = (LAS unsigned char*)lds_raw;
    int rep = 0; unsigned nbar = 0u;
    const int wave_s = __builtin_amdgcn_readfirstlane((int)threadIdx.x >> 6);
    for (int ph = a.ph_lo; ph < a.ph_hi; ++ph) {
        int tid; { int ln_; asm volatile("v_mbcnt_lo_u32_b32 %0, -1, 0\n\tv_mbcnt_hi_u32_b32 %0, -1, %0" : "=v"(ln_)); tid = wave_s * 64 + ln_; }
        int G = gridDim.x; asm volatile("" : "+s"(G));
        int bid = blockIdx.x; asm volatile("" : "+s"(bid));
        unsigned char* ws = a.ws; asm volatile("" : "+s"(ws));
        float* outp = a.out; asm volatile("" : "+s"(outp));
        const float* xin = (const float*)a.in[0]; asm volatile("" : "+s"(xin));
        const float* ln_g = (const float*)a.in[3]; asm volatile("" : "+s"(ln_g));
        const float* ln_b = (const float*)a.in[4]; asm volatile("" : "+s"(ln_b));
        const int wave = wave_s;
#define LANE_() ({ int l_ = tid & 63; asm volatile("" : "+v"(l_)); l_; })
        float* ada = (float*)(ws + WS_ADA); float* stats = (float*)(ws + WS_STATS);
        bf16* Hb = (bf16*)(ws + WS_H); bf16* ACT = (bf16*)(ws + WS_BIG);
        const int l = ph < 2 ? 0 : (ph - 2) / 12, k = ph < 2 ? ph : 2 + (ph - 2) % 12;
        unsigned char* wl = ws + WS_W + (size_t)l * W_LAYER;
        const float* ada_l = ada + (size_t)l * 8 * NADA;
#ifdef PHMASK
        if (!((PHMASK >> k) & 1)) continue;
#endif
#ifndef SKIPMASK
#define SKIPMASK 0x0
#endif
        if ((SKIPMASK >> k) & 1) continue;
        switch (k) {
        case 0: prologue_phase(a, lds, tid, LANE_(), wave, G); break;
        case 1: lnmod_phase<0>(xin, nullptr, nullptr, Hb, nullptr, nullptr, ada, LANE_(), wave, G); break;
        case 2: case 11: {
            pg8::Gemm g{Hb, (const bf16*)(wl + (k == 2 ? W_1IN : W_2IN)), M, 2 * FF, D}; pg8::StaticOrder S; S.init(M, 2 * FF, G, bid);
            pg8::EpiSwiglu E{ACT, FF};
            pg8::gemm_phase<pg8::EpiSwiglu, pg8::StaticOrder, true, true>(lds, g, S, E, tid);
        } break;
        case 3: case 9: case 12: {
            const int sub = k == 3 ? 0 : (k == 9 ? 1 : 2);
            const bf16* A = k == 9 ? Hb : ACT; const int K = k == 9 ? D : FF;
            const bf16* Bt = (const bf16*)(wl + (k == 3 ? W_1OUT : (k == 9 ? W_MOUT : W_2OUT)));
            const int mode = (l == 0 && sub == 0) ? 0 : 1;
            const int pl = sub == 0 ? l - 1 : l, ps = sub == 0 ? 2 : sub - 1;
            const int pidx = mode ? (pl * 3 + ps) : 0;
            pg8::Gemm g{A, Bt, M, D, K}; pg8::StaticOrder S; S.init(M, D, G, bid);
            pg8::EpiResid E{xin, outp, stats, ln_g + pidx * D, ln_b + pidx * D, ada_l + sub * 3072 + 2048, DN_ALPHA, sub == 1 ? 1.0f : 0.5f, mode, (unsigned)(size_t)(lds + 131072)};
            pg8::gemm_phase<pg8::EpiResid, pg8::StaticOrder, true, true>(lds, g, S, E, tid);
        } break;
        case 4: case 10: case 13: {
            const int sub = k == 4 ? 0 : (k == 10 ? 1 : 2);
            const float* lg = ln_g + (l * 3 + sub) * D; const float* lb = ln_b + (l * 3 + sub) * D;
            if (k == 13 && l == 1) lnmod_phase<2>(outp, outp, nullptr, nullptr, lg, lb, nullptr, LANE_(), wave, G);
            else { const float* am = k == 13 ? ada + (size_t)(l + 1) * 8 * NADA : ada_l + (sub + 1) * 3072;
                lnmod_phase<1>(outp, nullptr, stats, Hb, lg, lb, am, LANE_(), wave, G); }
        } break;
        case 5: {
            pg8::Gemm g{Hb, (const bf16*)(wl + W_MIN), M, NIN, D}; pg8::StaticOrder S; S.init(M, NIN, G, bid);
            pg8::EpiMixIn E{(bf16*)(ws + WS_BIG), (const float*)(ws + WS_ROPE), (const float*)(ws + WS_LB) + l * 512};
            pg8::gemm_phase<pg8::EpiMixIn, pg8::StaticOrder, true, true>(lds, g, S, E, tid);
        } break;
#ifndef SKIP_ATT
#define SKIP_ATT 0
#endif
        case 6: { if (!SKIP_ATT) att_phase(ws, lds, LANE_(), wave, G); __syncthreads();
                int tid2; { int ln2_; asm volatile("v_mbcnt_lo_u32_b32 %0, -1, 0\n\tv_mbcnt_hi_u32_b32 %0, -1, %0" : "=v"(ln2_)); tid2 = wave_s * 64 + ln2_; }
            unsigned char* ws2 = a.ws; asm volatile("" : "+s"(ws2));
            hgrn1_phase(ws2, (const float*)(ws2 + WS_LB) + l * 512, lds, tid2, tid2 & 63, wave_s, G); } break;
        case 7: hgrn2_phase(ws, tid, G); break;
        case 8: hgrn3_phase(ws, (const float*)(ws + WS_LB) + l * 512, (const float*)a.in[13] + l * 512, lds, tid, LANE_(), wave, G); break;
        default: break;
        }
#ifndef REPMASK
#define REPMASK 0
#endif
        if (((REPMASK >> k) & 1) && rep == 0 && !(k == 13 && l == 1)) { rep = 1; --ph; } else rep = 0;
        if (ph + 1 < a.ph_hi) {
            if (nbar == 0u) { cg::this_grid().sync(); nbar = 1u; }
            else { grid_bar((unsigned*)(a.ws + WS_LB + 8192), nbar, tid, gridDim.x); ++nbar; }
        }
    }
}

#ifndef MK_PER_PHASE
#define MK_PER_PHASE 0
#endif
extern "C" void kernel_launch(void* const* d_in, const int* in_sizes, int n_in, void* d_out, int out_size, void* d_ws, size_t ws_size, hipStream_t stream) {
    static int grid = 0;
    if (grid == 0) {
        if (n_in != 15 || in_sizes[0] != M * D || out_size != M * D || ws_size < WS_END) {
            fprintf(stderr, "kernel_launch: unexpected shapes (n_in %d, in0 %d, out %d, ws %zu, need %zu)\n", n_in, n_in > 0 ? in_sizes[0] : -1, out_size, ws_size, (size_t)WS_END); grid = -1; return; }
        int dev = 0, cus = 0, per_cu = 0;
        hipGetDevice(&dev); hipDeviceGetAttribute(&cus, hipDeviceAttributeMultiprocessorCount, dev);
        hipFuncSetAttribute((const void*)mk_fwd, hipFuncAttributeMaxDynamicSharedMemorySize, LDS_BYTES);
        hipOccupancyMaxActiveBlocksPerMultiprocessor(&per_cu, (const void*)mk_fwd, 512, LDS_BYTES);
        if (per_cu < 1) { fprintf(stderr, "kernel_launch: occupancy query says %d blocks per CU\n", per_cu); per_cu = 1; }
        (void)hipGetLastError();
        grid = cus * 1;
    }
    if (grid < 0) return;
    Args a{};
    for (int i = 0; i < 15; ++i) a.in[i] = d_in[i];
    a.out = (float*)d_out; a.ws = (unsigned char*)d_ws;
    for (int j = 0; j < 8; ++j) a.invf[j] = (float)std::pow(500000.0, -(double)j / 8.0);
#if MK_PER_PHASE
    for (int ph = 0; ph < N_PHASES; ++ph) { a.ph_lo = ph; a.ph_hi = ph + 1; hipLaunchKernelGGL(mk_fwd, dim3(grid), dim3(512), LDS_BYTES, stream, a); }
#else
    a.ph_lo = 0; a.ph_hi = N_PHASES;
    void* args[] = {&a};
    hipError_t e = hipLaunchCooperativeKernel((const void*)mk_fwd, dim3(grid), dim3(512), args, LDS_BYTES, stream);
    if (e != hipSuccess) fprintf(stderr, "cooperative launch failed: %s (grid %d)\n", hipGetErrorString(e), grid);
#endif
}
```

```cpp
#include <hip/hip_runtime.h>
#include <hip/hip_cooperative_groups.h>
#include <cstdio>
#include <cstdint>
#include <cmath>
namespace cg = cooperative_groups;
namespace pg8 {
#define PG8_LAS __attribute__((address_space(3)))
typedef unsigned short bf16_t;
typedef short bf16x8 __attribute__((ext_vector_type(8)));
typedef float f32x4 __attribute__((ext_vector_type(4)));
typedef unsigned u32x4 __attribute__((ext_vector_type(4)));
constexpr int BM = 256, BK = 64, HALF = 128, HTB = HALF * BK * 2  , STAGE_BYTES = 8 * HTB, NXCD = 8, WGM = 8;

__host__ __device__ __forceinline__ int lds_byte(int r, int c) { const int st = (r >> 4) * 2 + (c >> 5), rr = r & 15, cc = c & 31, ob = rr * 64 + cc * 2; return st * 1024 + (ob ^ (((ob >> 9) & 1) << 5)); }
__host__ __device__ __forceinline__ void stage_rc(int b, int& R, int& C) { const int st = b / 1024, sb = b % 1024, swz = sb ^ (((sb >> 9) & 1) << 5); R = (st >> 1) * 16 + swz / 64; C = (st & 1) * 32 + (swz % 64) / 2; }
__host__ __device__ __forceinline__ int perm32(int rho) { const int n = rho >> 4, i = rho & 15; return 8 * (i >> 2) + 4 * n + (i & 3); }

struct Unit { int pm, pn; };
struct Gemm { const bf16_t* A; const bf16_t* Bt; int M, N, K; };

struct StaticOrder {
    int nM, nN, nwg, G, c;
    __host__ __device__ void init(int M, int N, int G_, int c_) { nM = M / BM; nN = N / BM; nwg = nM * nN; G = G_; c = c_; }
    __host__ __device__ bool next(int i, Unit& u) const {
        const long L = (long)i * G + c; if (L >= nwg) return false;
        int wgid = (int)L; { const int q = nwg / NXCD, r = nwg % NXCD, xcd = wgid % NXCD, off = wgid / NXCD; wgid = (xcd < r ? xcd * (q + 1) : r * (q + 1) + (xcd - r) * q) + off; }
        const int nig = WGM * nN, gid = wgid / nig, fm = gid * WGM, gsz = (nM - fm) < WGM ? (nM - fm) : WGM;
        u.pm = fm + ((wgid % nig) % gsz); u.pn = (wgid % nig) / gsz; return true;
    }
    __device__ __forceinline__ void a_ready(const Unit&) const {}
    __device__ __forceinline__ void done(const Unit&) const {}
};

typedef float f32x2c __attribute__((ext_vector_type(2))); typedef __bf16 bf16x2c __attribute__((ext_vector_type(2)));
__device__ __forceinline__ unsigned cvt_pk_bf16(float lo, float hi) { const f32x2c v = {lo, hi}; const bf16x2c b = __builtin_convertvector(v, bf16x2c); return __builtin_bit_cast(unsigned, b); }
typedef float f32x2 __attribute__((ext_vector_type(2)));
#define PG8_GAS __attribute__((address_space(1)))
typedef _Float16 f16x2_t __attribute__((ext_vector_type(2)));
__device__ __forceinline__ unsigned cvt_pk_f16(float lo, float hi) { f16x2_t v = {(_Float16)lo, (_Float16)hi}; return __builtin_bit_cast(unsigned, v); }
__device__ __forceinline__ float silu_f(float v) { return v * __builtin_amdgcn_rcpf(1.f + __expf(-v)); }

struct EpiSwiglu {
    static constexpr bool PERM = true, AFTER_DRAIN = false;
    bf16_t* O; int ldc;
    __device__ __forceinline__ void operator()(const f32x4 (&acc)[2][2][4][2], const Unit& u, int wr, int wc, int fr, int fq) const {
        const int row0 = u.pm * BM + wr * 64 + fr; const int col0 = u.pn * HALF + wc * 32 + 8 * fq;
#pragma unroll
        for (int ai = 0; ai < 2; ++ai)
#pragma unroll
            for (int m = 0; m < 4; ++m) {
                bf16_t* rowp = O + (size_t)(row0 + ai * HALF + m * 16) * ldc + col0;
                const f32x4 g0 = acc[ai][0][m][0], g1 = acc[ai][0][m][1], u0 = acc[ai][1][m][0], u1 = acc[ai][1][m][1];
                u32x4 w;
                w.x = cvt_pk_bf16(silu_f(g0[0]) * u0[0], silu_f(g0[1]) * u0[1]); w.y = cvt_pk_bf16(silu_f(g0[2]) * u0[2], silu_f(g0[3]) * u0[3]);
                w.z = cvt_pk_bf16(silu_f(g1[0]) * u1[0], silu_f(g1[1]) * u1[1]); w.w = cvt_pk_bf16(silu_f(g1[2]) * u1[2], silu_f(g1[3]) * u1[3]);
                *(PG8_GAS u32x4*)rowp = w;
            }
    }
};

struct EpiResid {
    static constexpr bool PERM = false, AFTER_DRAIN = false;
    const float* xin; float* Z; const float* stats; const float* lng; const float* lnb; const float* gate; float alpha, resw; int mode; unsigned scr;
    __device__ __forceinline__ void operator()(const f32x4 (&acc)[2][2][4][2], const Unit& u, int wr, int wc, int fr, int fq) const {
        const int b = u.pm >> 5, lane = fr + 16 * fq;
        PG8_LAS unsigned char* sw = (PG8_LAS unsigned char*)(size_t)(scr + (unsigned)(wr * 4 + wc) * 2048u);
        const int wrow = fr * 128, rrow = lane >> 3, rch = lane & 7;
        f32x4 gt[2], lg[2], lb[2];
#pragma unroll
        for (int bj = 0; bj < 2; ++bj) {
            const int c = u.pn * BM + bj * HALF + wc * 32 + 4 * rch;
            gt[bj] = (*(const PG8_GAS f32x4*)(gate + (size_t)b * 9216 + c) + 1.f) * resw;
            lg[bj] = (f32x4){1.f, 1.f, 1.f, 1.f}; lb[bj] = (f32x4){0.f, 0.f, 0.f, 0.f};
            if (mode) { lg[bj] = *(const PG8_GAS f32x4*)(lng + c); lb[bj] = *(const PG8_GAS f32x4*)(lnb + c); }
        }
#pragma unroll
        for (int ai = 0; ai < 2; ++ai)
#pragma unroll
            for (int m = 0; m < 4; ++m) {
                const int r0 = u.pm * BM + ai * HALF + wr * 64 + m * 16;
                f32x2 st2[2];
#pragma unroll
                for (int s = 0; s < 2; ++s) { st2[s] = (f32x2){0.f, 1.f}; if (mode) st2[s] = *(const PG8_GAS f32x2*)(stats + 2 * (size_t)(r0 + 8 * s + rrow)); }
#pragma unroll
                for (int bj = 0; bj < 2; ++bj) {
                    const size_t off0 = (size_t)(r0 + rrow) * 1024 + u.pn * BM + bj * HALF + wc * 32 + 4 * rch;
                    f32x4 xo[2];
#pragma unroll
                    for (int s = 0; s < 2; ++s) xo[s] = mode ? *(const PG8_GAS f32x4*)(Z + off0 + (size_t)s * 8192) : *(const PG8_GAS f32x4*)(xin + off0 + (size_t)s * 8192);
#pragma unroll
                    for (int n = 0; n < 2; ++n) *(PG8_LAS f32x4*)(sw + wrow + (((4 * n + fq) ^ (fr & 7)) << 4)) = acc[ai][bj][m][n];
                    asm volatile("s_waitcnt lgkmcnt(0)" ::: "memory");
                    f32x4 av[2];
#pragma unroll
                    for (int s = 0; s < 2; ++s) av[s] = *(const PG8_LAS f32x4*)(sw + (8 * s + rrow) * 128 + ((rch ^ ((8 * s + rrow) & 7)) << 4));
                    asm volatile("s_waitcnt lgkmcnt(0)" ::: "memory");
#pragma unroll
                    for (int s = 0; s < 2; ++s) {
                        f32x4 xv = xo[s];
                        if (mode) xv = (xv - st2[s].x) * st2[s].y * lg[bj] + lb[bj];
                        *(PG8_GAS f32x4*)(Z + off0 + (size_t)s * 8192) = xv * alpha + gt[bj] * av[s];
                    }
                }
            }
    }
};

__device__ __forceinline__ float gate_logf(float fp, float lb) {
    const float e = __expf(-fabsf(fp)), l1pe = __logf(1.f + e);
    return (fp >= 0.f ? __logf(1.f + lb * e) : (lb > 0.f ? __logf(lb + e) : fp)) - l1pe;
}
struct EpiMixIn {
    static constexpr bool PERM = true, AFTER_DRAIN = false;
    bf16_t* proj; const float* rope; const float* lbl;
    __device__ __forceinline__ void operator()(const f32x4 (&acc)[2][2][4][2], const Unit& u, int wr, int wc, int fr, int fq) const {
        const int seg = u.pn >> 1; const int rbase = u.pm * BM + wr * 64 + fr; const int b = u.pm >> 5;
        bf16_t* segp = proj + (size_t)seg * ((size_t)65536 * 512);
#pragma unroll
        for (int bj = 0; bj < 2; ++bj) {
            const int wcol = (u.pn & 1) * 256 + bj * HALF + wc * 32 + 8 * fq;
            if (seg < 3) {
                const int head = wcol >> 6, ch = wcol & 63;
                const bool rotw = (seg < 2) && ((wc & 1) == 0);
#pragma unroll
                for (int ai = 0; ai < 2; ++ai)
#pragma unroll
                    for (int m = 0; m < 4; ++m) {
                        const int r = rbase + ai * HALF + m * 16; const int s = r & 8191;
                        f32x4 v0 = acc[ai][bj][m][0], v1 = acc[ai][bj][m][1];
                        if (rotw) {
                            f32x4 p0, p1;
#pragma unroll
                            for (int j = 0; j < 4; ++j) { p0[j] = __shfl_xor(v0[j], 16); p1[j] = __shfl_xor(v1[j], 16); }
                            if (fq < 2) {
                                const f32x4 c0 = *(const PG8_GAS f32x4*)(rope + (size_t)r * 16), c1 = *(const PG8_GAS f32x4*)(rope + (size_t)r * 16 + 4);
                                const f32x4 s0 = *(const PG8_GAS f32x4*)(rope + (size_t)r * 16 + 8), s1 = *(const PG8_GAS f32x4*)(rope + (size_t)r * 16 + 12);
                                if (fq == 0) { v0 = v0 * c0 - p0 * s0; v1 = v1 * c1 - p1 * s1; }
                                else { v0 = v0 * c0 + p0 * s0; v1 = v1 * c1 + p1 * s1; }
                            }
                        }
                        if (seg == 0) { v0 = v0 * 0.18033688011112042f; v1 = v1 * 0.18033688011112042f; }
                        u32x4 w; w.x = cvt_pk_bf16(v0[0], v0[1]); w.y = cvt_pk_bf16(v0[2], v0[3]); w.z = cvt_pk_bf16(v1[0], v1[1]); w.w = cvt_pk_bf16(v1[2], v1[3]);
                        *(PG8_GAS u32x4*)(segp + ((size_t)((b * 8 + head) * 8192 + s)) * 64 + ch) = w;
                    }
            } else {
#pragma unroll
                for (int ai = 0; ai < 2; ++ai)
#pragma unroll
                    for (int m = 0; m < 4; ++m) {
                        const int r = rbase + ai * HALF + m * 16;
                        f32x4 v0 = acc[ai][bj][m][0], v1 = acc[ai][bj][m][1];
                        if (seg == 3 || seg == 6) {
#pragma unroll
                            for (int j = 0; j < 4; ++j) { v0[j] = silu_f(v0[j]); v1[j] = silu_f(v1[j]); }
                        }
                        if (seg == 4) {
                            const f32x4 l0 = *(const PG8_GAS f32x4*)(lbl + wcol), l1 = *(const PG8_GAS f32x4*)(lbl + wcol + 4);
#pragma unroll
                            for (int j = 0; j < 4; ++j) { v0[j] = gate_logf(v0[j], l0[j]); v1[j] = gate_logf(v1[j], l1[j]); }
                        }
                        u32x4 w;
                        if (seg == 4) { w.x = cvt_pk_f16(v0[0], v0[1]); w.y = cvt_pk_f16(v0[2], v0[3]); w.z = cvt_pk_f16(v1[0], v1[1]); w.w = cvt_pk_f16(v1[2], v1[3]); }
                        else { w.x = cvt_pk_bf16(v0[0], v0[1]); w.y = cvt_pk_bf16(v0[2], v0[3]); w.z = cvt_pk_bf16(v1[0], v1[1]); w.w = cvt_pk_bf16(v1[2], v1[3]); }
                        *(PG8_GAS u32x4*)(segp + (size_t)r * 512 + wcol) = w;
                    }
            }
        }
    }
};

template <class Epi, class Sched, bool ALIGN_EPI = false, bool SP2 = false>
__device__ __forceinline__ void gemm_phase(PG8_LAS unsigned char* lds, const Gemm g, const Sched& S, const Epi& E, const int tid) {
    const int wid = __builtin_amdgcn_readfirstlane(tid >> 6), lane = tid & 63, wr = wid >> 2, wc = wid & 3, fr = lane & 15, fq = lane >> 4;
    const int K = g.K, nt = K / BK;
    unsigned voffA[2], voffB[2];
#pragma unroll
    for (int i = 0; i < 2; ++i) { int R, C; stage_rc(tid * 16 + i * 8192, R, C); const int Rb = Epi::PERM ? ((R & ~31) + perm32(R & 31)) : R;
        voffA[i] = (unsigned)(R * K + C) * 2u; voffB[i] = (unsigned)(Rb * K + C) * 2u; }
    const size_t kstep = (size_t)(BK * 2);
    const size_t hstep = (size_t)HALF * K * 2;
    const size_t tstep = 2 * hstep;
    const unsigned ldsw = (unsigned)wid * 1024u;
    const int aoff = lds_byte(wr * 64 + fr, fq * 8), boff = lds_byte(wc * 32 + fr, fq * 8);
#define PG8_SA(b, h) (((b) * 2 + (h)) * HTB)
#define PG8_SB(b, h) ((4 + (b) * 2 + (h)) * HTB)
#define PG8_STAGE(bufoff, gbase, voff) do { _Pragma("unroll") for (int _i = 0; _i < 2; ++_i) \
        __builtin_amdgcn_global_load_lds((const unsigned*)((const char*)(gbase) + (voff)[_i]), (PG8_LAS unsigned*)(lds + (bufoff) + ldsw + _i * 8192), 16, 0, 0); } while (0)
#define PG8_LDA(dst, b, h) do { _Pragma("unroll") for (int m = 0; m < 4; ++m) _Pragma("unroll") for (int k = 0; k < 2; ++k) dst[m][k] = *(const PG8_LAS bf16x8*)(lds + PG8_SA(b, h) + aoff + m * 2048 + k * 1024); } while (0)
#define PG8_LDB(dst, b, h) do { _Pragma("unroll") for (int n = 0; n < 2; ++n) _Pragma("unroll") for (int k = 0; k < 2; ++k) dst[n][k] = *(const PG8_LAS bf16x8*)(lds + PG8_SB(b, h) + boff + n * 2048 + k * 1024); } while (0)
#define PG8_MMA(ai, bj, At, Bt) do { __builtin_amdgcn_s_setprio(1); _Pragma("unroll") for (int m = 0; m < 4; ++m) _Pragma("unroll") for (int n = 0; n < 2; ++n) _Pragma("unroll") for (int k = 0; k < 2; ++k) \
        acc[ai][bj][m][n] = __builtin_amdgcn_mfma_f32_16x16x32_bf16(Bt[n][k], At[m][k], acc[ai][bj][m][n], 0, 0, 0); __builtin_amdgcn_s_setprio(0); } while (0)
#define PG8_WAIT_V(n) asm volatile("s_waitcnt vmcnt(" #n ")" ::: "memory")
#define PG8_WAIT_L(n) asm volatile("s_waitcnt lgkmcnt(" #n ")" ::: "memory")
#define PG8_BAR __builtin_amdgcn_s_barrier()
#define PG8_SCHED __builtin_amdgcn_sched_barrier(0)
    Unit cur, nxt; int ui = 0;
    if (!S.next(0, cur)) return;
    f32x4 acc[2][2][4][2];
#pragma unroll
    for (int a = 0; a < 2; ++a)
#pragma unroll
        for (int b = 0; b < 2; ++b)
#pragma unroll
            for (int m = 0; m < 4; ++m)
#pragma unroll
                for (int n = 0; n < 2; ++n) acc[a][b][m][n] = (f32x4){0.f, 0.f, 0.f, 0.f};
    bf16x8 At[4][2], B0[2][2], B1[2][2];
    const char* cA = (const char*)g.A + (size_t)cur.pm * tstep; const char* cB = (const char*)g.Bt + (size_t)cur.pn * tstep;
    S.a_ready(cur);
    if constexpr (SP2) {
        PG8_STAGE(PG8_SB(0, 0), cB, voffB); PG8_STAGE(PG8_SB(0, 1), cB + hstep, voffB); PG8_STAGE(PG8_SA(0, 0), cA, voffA); PG8_STAGE(PG8_SA(0, 1), cA + hstep, voffA);
        if (wr == 1) PG8_BAR;
        PG8_WAIT_V(2); PG8_BAR;
        PG8_STAGE(PG8_SB(1, 0), cB + kstep, voffB); PG8_STAGE(PG8_SA(1, 0), cA + kstep, voffA); PG8_STAGE(PG8_SB(1, 1), cB + hstep + kstep, voffB);
        PG8_WAIT_V(6); PG8_BAR;
    } else {
        PG8_STAGE(PG8_SB(0, 0), cB, voffB); PG8_STAGE(PG8_SA(0, 0), cA, voffA); PG8_STAGE(PG8_SB(0, 1), cB + hstep, voffB); PG8_STAGE(PG8_SA(0, 1), cA + hstep, voffA);
        if (wr == 1) PG8_BAR;
        PG8_WAIT_V(4); PG8_BAR;
        PG8_STAGE(PG8_SB(1, 0), cB + kstep, voffB); PG8_STAGE(PG8_SA(1, 0), cA + kstep, voffA); PG8_STAGE(PG8_SB(1, 1), cB + hstep + kstep, voffB);
        PG8_WAIT_V(6); PG8_BAR;
    }
    for (;;) {
        const bool has_next = S.next(ui + 1, nxt);
        const char* nA = has_next ? (const char*)g.A + (size_t)nxt.pm * tstep : cA; const char* nB = has_next ? (const char*)g.Bt + (size_t)nxt.pn * tstep : cB;
        for (int t = 0; t < nt; t += 2) {
            const bool last = (t == nt - 2);
            const char* a1 = cA + (size_t)(t + 1) * kstep;
            const char* a2 = last ? nA : cA + (size_t)(t + 2) * kstep; const char* b2 = last ? nB : cB + (size_t)(t + 2) * kstep;
            const char* a3 = a2 + kstep; const char* b3 = b2 + kstep;
            if (last && has_next) S.a_ready(nxt);
            if constexpr (SP2) {
            PG8_LDB(B0, 0, 0); PG8_LDB(B1, 0, 1); PG8_SCHED; PG8_LDA(At, 0, 0); PG8_STAGE(PG8_SA(1, 1), a1 + hstep, voffA);
            PG8_WAIT_V(8); PG8_WAIT_L(0); PG8_BAR; PG8_MMA(0, 0, At, B0); PG8_MMA(0, 1, At, B1); PG8_BAR; PG8_SCHED;
            PG8_LDA(At, 0, 1); PG8_STAGE(PG8_SB(0, 0), b2, voffB); PG8_STAGE(PG8_SB(0, 1), b2 + hstep, voffB); PG8_STAGE(PG8_SA(0, 0), a2, voffA);
            PG8_WAIT_V(8); PG8_WAIT_L(0); PG8_BAR; PG8_MMA(1, 0, At, B0); PG8_MMA(1, 1, At, B1); PG8_BAR; PG8_SCHED;
            PG8_LDB(B0, 1, 0); PG8_LDB(B1, 1, 1); PG8_SCHED; PG8_LDA(At, 1, 0); PG8_STAGE(PG8_SA(0, 1), a2 + hstep, voffA);
            PG8_WAIT_V(8); PG8_WAIT_L(0); PG8_BAR; PG8_MMA(0, 0, At, B0); PG8_MMA(0, 1, At, B1); PG8_BAR; PG8_SCHED;
            PG8_LDA(At, 1, 1); PG8_STAGE(PG8_SB(1, 0), b3, voffB); PG8_STAGE(PG8_SB(1, 1), b3 + hstep, voffB); PG8_STAGE(PG8_SA(1, 0), a3, voffA);
            PG8_WAIT_V(8); PG8_WAIT_L(0); PG8_BAR; PG8_MMA(1, 0, At, B0); PG8_MMA(1, 1, At, B1); PG8_BAR; PG8_SCHED;
            } else {
            PG8_LDB(B0, 0, 0); PG8_SCHED; PG8_LDA(At, 0, 0); PG8_STAGE(PG8_SA(1, 1), a1 + hstep, voffA);
            PG8_WAIT_L(8); PG8_BAR; PG8_WAIT_L(0); PG8_MMA(0, 0, At, B0); PG8_BAR; PG8_SCHED;
            PG8_LDB(B1, 0, 1); PG8_STAGE(PG8_SB(0, 0), b2, voffB);
            PG8_BAR; PG8_WAIT_L(0); PG8_MMA(0, 1, At, B1); PG8_BAR;
            PG8_LDA(At, 0, 1); PG8_STAGE(PG8_SA(0, 0), a2, voffA);
            PG8_BAR; PG8_WAIT_L(0); PG8_MMA(1, 0, At, B0); PG8_BAR; PG8_SCHED;
            PG8_STAGE(PG8_SB(0, 1), b2 + hstep, voffB);
            PG8_WAIT_V(6); PG8_BAR; PG8_MMA(1, 1, At, B1); PG8_BAR;
            PG8_LDB(B0, 1, 0); PG8_SCHED; PG8_LDA(At, 1, 0); PG8_STAGE(PG8_SA(0, 1), a2 + hstep, voffA);
            PG8_WAIT_L(8); PG8_BAR; PG8_WAIT_L(0); PG8_MMA(0, 0, At, B0); PG8_BAR; PG8_SCHED;
            PG8_LDB(B1, 1, 1); PG8_STAGE(PG8_SB(1, 0), b3, voffB);
            PG8_BAR; PG8_WAIT_L(0); PG8_MMA(0, 1, At, B1); PG8_BAR;
            PG8_LDA(At, 1, 1); PG8_STAGE(PG8_SA(1, 0), a3, voffA);
            PG8_BAR; PG8_WAIT_L(0); PG8_MMA(1, 0, At, B0); PG8_BAR; PG8_SCHED;
            PG8_STAGE(PG8_SB(1, 1), b3 + hstep, voffB);
            PG8_WAIT_V(6); PG8_BAR; PG8_MMA(1, 1, At, B1); PG8_BAR;
            }
        }
        if constexpr (ALIGN_EPI) { if (wr == 0) PG8_BAR; }
        if constexpr (!Epi::AFTER_DRAIN) { E(acc, cur, wr, wc, fr, fq); S.done(cur); }
        if (!has_next) break;
#pragma unroll
        for (int a = 0; a < 2; ++a)
#pragma unroll
            for (int b = 0; b < 2; ++b)
#pragma unroll
                for (int m = 0; m < 4; ++m)
#pragma unroll
                    for (int n = 0; n < 2; ++n) acc[a][b][m][n] = (f32x4){0.f, 0.f, 0.f, 0.f};
        cur = nxt; cA = nA; cB = nB; ++ui;
        if constexpr (ALIGN_EPI) { if (wr == 1) PG8_BAR; }
    }
    PG8_WAIT_V(0);
    if constexpr (!ALIGN_EPI) { if (wr == 0) PG8_BAR; }
    PG8_BAR;
    if constexpr (Epi::AFTER_DRAIN) { E.fused(acc, cur, wr, wc, fr, fq, lds, wid, lane); S.done(cur); }
#undef PG8_SA
#undef PG8_SB
#undef PG8_STAGE
#undef PG8_LDA
#undef PG8_LDB
#undef PG8_MMA
#undef PG8_WAIT_V
#undef PG8_WAIT_L
#undef PG8_BAR
#undef PG8_SCHED
}
}

#define LAS __attribute__((address_space(3)))
typedef unsigned short bf16;
typedef unsigned v4u __attribute__((ext_vector_type(4)));
typedef unsigned v2u __attribute__((ext_vector_type(2)));
typedef float f32x4 __attribute__((ext_vector_type(4)));
typedef float f32x2v __attribute__((ext_vector_type(2)));
typedef float f32x16 __attribute__((ext_vector_type(16)));
typedef short bf16x8 __attribute__((ext_vector_type(8)));
typedef short s16x4 __attribute__((ext_vector_type(4)));
typedef short v4i16_t __attribute__((ext_vector_type(4)));

constexpr int NB = 8, SEQ = 8192, M = NB * SEQ, D = 1024, FF = 2816, NIN = 3584, NADA = 9216;
constexpr float LN_EPS = 1e-5f, RMS_EPS = 1e-6f, DN_ALPHA = 1.41421356237309515f;
constexpr size_t MiB = 1u << 20;
constexpr size_t WS_ADA = 0, WS_STATS = 1 * MiB, WS_LB = 1 * MiB + 512 * 1024, WS_ROPE = 2 * MiB, WS_HDEC = 6 * MiB, WS_ML = 8 * MiB;
constexpr size_t WS_W = 16 * MiB;
constexpr size_t W_LAYER = 42 * MiB, W_1IN = 0, W_1OUT = 11 * MiB, W_2IN = 11 * MiB + 5632 * 1024, W_2OUT = 22 * MiB + 5632 * 1024, W_MIN = 33 * MiB, W_MOUT = 40 * MiB;
constexpr size_t WS_H = 112 * MiB;
constexpr size_t WS_BIG = 240 * MiB;
constexpr size_t WS_DS = 688 * MiB;
constexpr size_t WS_OP = 816 * MiB;
constexpr size_t WS_END = 944 * MiB;
constexpr size_t SEG = (size_t)65536 * 512;
constexpr int LDS_BYTES = 147456;

__device__ __forceinline__ unsigned f2bf(float f) { unsigned u = __builtin_bit_cast(unsigned, f); return (u + 0x7fffu + ((u >> 16) & 1u)) >> 16; }
__device__ __forceinline__ unsigned pk2(float lo, float hi) { return pg8::cvt_pk_bf16(lo, hi); }
__device__ __forceinline__ float bf2f(unsigned short v) { return __builtin_bit_cast(float, (unsigned)v << 16); }
__device__ __forceinline__ float h2f(unsigned short v) { return (float)__builtin_bit_cast(_Float16, v); }
__device__ __forceinline__ float wave_sum(float v) {
#pragma unroll
    for (int o = 1; o < 64; o <<= 1) v += __shfl_xor(v, o);
    return v;
}
#define LDS_WAIT() asm volatile("s_waitcnt lgkmcnt(0)" ::: "memory")
#define GAS __attribute__((address_space(1)))
template <class T> __device__ __forceinline__ T gld(const void* p) { return *(const GAS T*)p; }
template <class T> __device__ __forceinline__ void gst(void* p, T v) { *(GAS T*)p = v; }
template <class T> __device__ __forceinline__ T gld_nt(const void* p) { return __builtin_nontemporal_load((const GAS T*)p); }

struct Args { const void* in[15]; float* out; unsigned char* ws; float invf[8]; int ph_lo, ph_hi; };

__device__ __forceinline__ void transpose_item(const float* W, int K, int N, bf16* WT, LAS float* scr, int item, int lane, bool swiglu) {
    const int nblk = N / 32, kb = item / nblk, nb = item % nblk, k0 = 64 * kb, n0 = 32 * nb;
    int sc0 = n0;
    if (swiglu) { const int pn = n0 >> 8, w = n0 & 255; sc0 = (w >> 7) * FF + pn * 128 + (w & 127); }
    float wv[32];
#pragma unroll
    for (int i = 0; i < 32; ++i) wv[i] = W[(size_t)(k0 + 2 * i + (lane >> 5)) * N + sc0 + (lane & 31)];
#pragma unroll
    for (int i = 0; i < 32; ++i) scr[(2 * i + (lane >> 5)) * 33 + (lane & 31)] = wv[i];
    LDS_WAIT();
    const int c = lane & 7;
#pragma unroll
    for (int j = 0; j < 4; ++j) { const int n = (lane >> 3) + 8 * j; const LAS float* s = scr + (8 * c) * 33 + n;
        v4u o; o.x = pk2(s[0 * 33], s[1 * 33]); o.y = pk2(s[2 * 33], s[3 * 33]); o.z = pk2(s[4 * 33], s[5 * 33]); o.w = pk2(s[6 * 33], s[7 * 33]);
        *(v4u*)(WT + (size_t)(n0 + n) * K + k0 + 8 * c) = o; }
    LDS_WAIT();
}

__device__ __forceinline__ void prologue_phase(const Args& a, LAS unsigned char* lds, int tid, int lane, int wave, int G) {
    unsigned char* ws = a.ws;
    const int gw = blockIdx.x * 8 + wave, NGW = G * 8;
    {
        LAS float* scr = (LAS float*)(lds + wave * 16384);
        constexpr int I_FI = 16 * 176, I_FO = 44 * 32, I_MI = 16 * 112, I_MO = 16 * 32, I_L = 2 * I_FI + 2 * I_FO + I_MI + I_MO;
        for (int it = gw; it < 2 * I_L; it += NGW) {
            const int l = it / I_L; int r = it % I_L;
            unsigned char* wl = ws + WS_W + (size_t)l * W_LAYER;
            if (r < I_FI) { transpose_item((const float*)a.in[7] + (size_t)l * D * 2 * FF, D, 2 * FF, (bf16*)(wl + W_1IN), scr, r, lane, true); continue; } r -= I_FI;
            if (r < I_FI) { transpose_item((const float*)a.in[9] + (size_t)l * D * 2 * FF, D, 2 * FF, (bf16*)(wl + W_2IN), scr, r, lane, true); continue; } r -= I_FI;
            if (r < I_FO) { transpose_item((const float*)a.in[8] + (size_t)l * FF * D, FF, D, (bf16*)(wl + W_1OUT), scr, r, lane, false); continue; } r -= I_FO;
            if (r < I_FO) { transpose_item((const float*)a.in[10] + (size_t)l * FF * D, FF, D, (bf16*)(wl + W_2OUT), scr, r, lane, false); continue; } r -= I_FO;
            if (r < I_MI) { transpose_item((const float*)a.in[11] + (size_t)l * D * NIN, D, NIN, (bf16*)(wl + W_MIN), scr, r, lane, false); continue; } r -= I_MI;
            transpose_item((const float*)a.in[12] + (size_t)l * D * D, D, D, (bf16*)(wl + W_MOUT), scr, r, lane, false);
        }
    }
    __syncthreads();
    {
        const float* cin = (const float*)a.in[1]; const float* aw = (const float*)a.in[5]; const float* ab = (const float*)a.in[6];
        float* ada = (float*)(ws + WS_ADA);
        LAS float* red = (LAS float*)lds;
        LAS float* cond = (LAS float*)(lds + 16384);
        for (int i = tid; i < 8 * D; i += 512) { const float cv = cin[i]; cond[i] = cv * __builtin_amdgcn_rcpf(1.f + __expf(-cv)); }
        __syncthreads();
        for (int it = blockIdx.x; it < 512; it += G) {
            const int l = it >> 8, n0 = (it & 255) * 36;
            float acc[8];
#pragma unroll
            for (int b = 0; b < 8; ++b) acc[b] = 0.f;
            if (lane < 36) {
                const float* wp = aw + ((size_t)l * D + wave * 128) * NADA + n0 + lane;
#pragma unroll 1
                for (int k0 = 0; k0 < 128; k0 += 32) {
                    float w[32];
#pragma unroll
                    for (int k = 0; k < 32; ++k) w[k] = wp[(size_t)(k0 + k) * NADA];
#pragma unroll
                    for (int k = 0; k < 32; ++k) {
#pragma unroll
                        for (int b = 0; b < 8; ++b) acc[b] += cond[b * D + wave * 128 + k0 + k] * w[k];
                    }
                }
#pragma unroll
                for (int b = 0; b < 8; ++b) red[(wave * 8 + b) * 36 + lane] = acc[b];
            }
            __syncthreads();
            if (tid < 288) { const int b = tid / 36, n = tid % 36; float s = ab[l * NADA + n0 + n];
#pragma unroll
                for (int w = 0; w < 8; ++w) s += red[(w * 8 + b) * 36 + n];
                ada[((size_t)l * 8 + b) * NADA + n0 + n] = s; }
            __syncthreads();
        }
    }
    {
        const float* lg = (const float*)a.in[14]; float* lbv = (float*)(ws + WS_LB);
        const int gt = blockIdx.x * 512 + tid;
        if (gt < 9) ((unsigned*)(ws + WS_LB + 8192))[64 * gt] = 0u;
        if (gt < 512) { const float l0 = lg[gt], l1 = lg[512 + gt]; lbv[gt] = 0.f; lbv[512 + gt] = 1.f / (1.f + __expf(l0 - l1)); }
    }
    {
        const int* pos = (const int*)a.in[2]; float* rope = (float*)(ws + WS_ROPE);
        for (int r = blockIdx.x * 512 + tid; r < M; r += G * 512) {
            const float pf = (float)pos[r];
            f32x4 cv[2], sv[2];
#pragma unroll
            for (int j = 0; j < 8; ++j) {
                const float ang = pf * a.invf[j];
                const double rev = (double)ang * 0.15915494309189535; const float fr = (float)(rev - floor(rev));
                cv[j >> 2][j & 3] = __builtin_amdgcn_cosf(fr); sv[j >> 2][j & 3] = __builtin_amdgcn_sinf(fr);
            }
            *(f32x4*)(rope + (size_t)r * 16) = cv[0]; *(f32x4*)(rope + (size_t)r * 16 + 4) = cv[1];
            *(f32x4*)(rope + (size_t)r * 16 + 8) = sv[0]; *(f32x4*)(rope + (size_t)r * 16 + 12) = sv[1];
        }
    }
}

template <int MODE>
__device__ __forceinline__ void lnmod_phase(const float* src, float* dst, float* stats, bf16* H, const float* lng, const float* lnb, const float* ada_mod  , int lane, int wave, int G) {
    const int gw = blockIdx.x * 8 + wave, NGW = G * 8;
    for (int chunk = gw; chunk < M / 32; chunk += NGW) {
        const int b = chunk >> 8;
        f32x4 g[4], bb[4], sc[4], sh[4];
#pragma unroll
        for (int j = 0; j < 4; ++j) {
            const int c = 4 * lane + 256 * j;
            if (MODE != 0) { g[j] = gld<f32x4>(lng + c); bb[j] = gld<f32x4>(lnb + c); }
            if (MODE != 2) { sh[j] = gld<f32x4>(ada_mod + (size_t)b * NADA + c); sc[j] = gld<f32x4>(ada_mod + (size_t)b * NADA + 1024 + c) + 1.f; }
        }
        f32x4 v[4], nx[4];
        const float* rp = src + (size_t)chunk * 32 * D + 4 * lane;
#pragma unroll
        for (int j = 0; j < 4; ++j) nx[j] = gld_nt<f32x4>(rp + 256 * j);
        for (int i = 0; i < 32; ++i) {
            const int r = chunk * 32 + i;
#pragma unroll
            for (int j = 0; j < 4; ++j) v[j] = nx[j];
            if (i + 1 < 32) {
#pragma unroll
                for (int j = 0; j < 4; ++j) nx[j] = gld_nt<f32x4>(rp + (size_t)(i + 1) * D + 256 * j);
            }
            if (MODE != 0) {
                float s = 0.f;
#pragma unroll
                for (int j = 0; j < 4; ++j) s += (v[j].x + v[j].y) + (v[j].z + v[j].w);
                const float mean = wave_sum(s) * (1.f / D); float s2 = 0.f;
#pragma unroll
                for (int j = 0; j < 4; ++j) { v[j] = v[j] - mean; s2 += (v[j].x * v[j].x + v[j].y * v[j].y) + (v[j].z * v[j].z + v[j].w * v[j].w); }
                const float rstd = 1.f / sqrtf(wave_sum(s2) * (1.f / D) + LN_EPS);
                if (MODE == 1 && lane == 0) gst<f32x2v>(stats + 2 * (size_t)r, (f32x2v){mean, rstd});
#pragma unroll
                for (int j = 0; j < 4; ++j) v[j] = v[j] * rstd * g[j] + bb[j];
            }
            if (MODE == 2) {
#pragma unroll
                for (int j = 0; j < 4; ++j) gst<f32x4>(dst + (size_t)r * D + 4 * lane + 256 * j, v[j]);
            } else {
#pragma unroll
                for (int j = 0; j < 4; ++j) { const f32x4 hv = v[j] * sc[j] + sh[j]; v2u o; o.x = pk2(hv.x, hv.y); o.y = pk2(hv.z, hv.w);
                    gst<v2u>(H + (size_t)r * D + 4 * lane + 256 * j, o); }
            }
        }
    }
}

__device__ __forceinline__ int crow16(int i, int h) { return (i & 3) + 8 * (i >> 2) + 4 * h; }
__device__ __forceinline__ s16x4 vtr(LAS const unsigned char* p) { return __builtin_bit_cast(s16x4, __builtin_amdgcn_ds_read_tr16_b64_v4i16((LAS v4i16_t*)p)); }
constexpr int VP = 128;

struct AttJob { int pos0, d, brmode, bar_after, b, head; size_t hb; };
__device__ __forceinline__ bool att_params(int q, int nun, int G, int wave, AttJob& P) {
    const int ui = q / 6, r = q - 6 * ui, br = r >> 1, jj = r & 1;
    if (ui >= nun) return false;
    int uid;
    if (G == 256) { const int x = blockIdx.x & 7, sl = blockIdx.x >> 3; uid = ((x * 8 + (sl >> 2)) << 3) + (sl & 3) * 2 + ui; }
    else { uid = blockIdx.x + ui * G; if (uid >= 512) return false; }
    const int bh = uid >> 3, T0 = (uid & 7) * 1024;
    const int d = br == 0 ? 16 : (br == 1 ? 4 : 1), pj = wave + 8 * jj;
    const int p0 = d == 1 ? 64 * pj : (d == 4 ? 256 * (pj & 3) + (pj >> 2) : pj);
    P.pos0 = T0 + p0; P.d = d; P.brmode = br; P.bar_after = (jj == 1 && br < 2) ? 1 : 0; P.b = bh >> 3; P.head = bh & 7; P.hb = (size_t)bh * SEQ;
    return true;
}
__device__ __forceinline__ void att_block(const bf16x8 (&kf)[4], const bf16x8 (&qf)[4], const bf16x8 (&va)[4], f32x16& o0, f32x16& o1, float& mrun, float& lrun, bool domask, int lo_, int hi_) {
    f32x16 st;
#pragma unroll
    for (int i = 0; i < 16; ++i) st[i] = 0.f;
#pragma unroll
    for (int kk = 0; kk < 4; ++kk) st = __builtin_amdgcn_mfma_f32_32x32x16_bf16(kf[kk], qf[kk], st, 0, 0, 0);
    if (domask) {
        asm volatile("" : "+v"(lo_), "+v"(hi_));
#pragma unroll
        for (int i = 0; i < 16; ++i) { const int ci = (i & 3) + 8 * (i >> 2); st[i] = ((ci - lo_) | (hi_ - ci)) < 0 ? -INFINITY : st[i]; }
    }
    float bmax = -INFINITY;
#pragma unroll
    for (int i = 0; i < 16; ++i) bmax = fmaxf(bmax, st[i]);
    bmax = fmaxf(bmax, __shfl_xor(bmax, 32));
    const float mnew = fmaxf(mrun, bmax);
    float lsum = 0.f;
#pragma unroll
    for (int i = 0; i < 16; ++i) { st[i] = __builtin_amdgcn_exp2f(st[i] - mnew); lsum += st[i]; }
    lsum += __shfl_xor(lsum, 32);
    const float alpha = __builtin_amdgcn_exp2f(mrun - mnew);
    lrun = lrun * alpha + lsum; mrun = mnew;
#pragma unroll
    for (int i = 0; i < 16; ++i) { o0[i] *= alpha; o1[i] *= alpha; }
#pragma unroll
    for (int s = 0; s < 2; ++s) { v4u w; w.x = pk2(st[8 * s], st[8 * s + 1]); w.y = pk2(st[8 * s + 2], st[8 * s + 3]); w.z = pk2(st[8 * s + 4], st[8 * s + 5]); w.w = pk2(st[8 * s + 6], st[8 * s + 7]);
        const bf16x8 pb = __builtin_bit_cast(bf16x8, w);
        o0 = __builtin_amdgcn_mfma_f32_32x32x16_bf16(va[2 * s], pb, o0, 0, 0, 0);
        o1 = __builtin_amdgcn_mfma_f32_32x32x16_bf16(va[2 * s + 1], pb, o1, 0, 0, 0); }
}
__device__ __forceinline__ void att_merge(f32x16& o0, f32x16& o1, float mrun, float lrun, int qpos, int brmode, bf16* OPh, float* MLh, bf16* outp, int h) {
    bf16* op = OPh + (size_t)qpos * 64 + 8 * h;
    if (brmode != 0) {
        const f32x2v mlp = gld<f32x2v>(MLh + 2 * (size_t)qpos);
        v4u pv[4];
#pragma unroll
        for (int g = 0; g < 4; ++g) pv[g] = gld<v4u>(op + 16 * g);
        const float mnew = fmaxf(mrun, mlp.x), ao = __builtin_amdgcn_exp2f(mlp.x - mnew), an = __builtin_amdgcn_exp2f(mrun - mnew);
        lrun = lrun * an + mlp.y * ao; mrun = mnew;
#pragma unroll
        for (int g = 0; g < 4; ++g) {
            const auto rx = __builtin_amdgcn_permlane32_swap(pv[g].x, pv[g].z, false, false);
            const auto ry = __builtin_amdgcn_permlane32_swap(pv[g].y, pv[g].w, false, false);
            const unsigned wa[2] = {rx[0], ry[0]}, wb[2] = {rx[1], ry[1]};
#pragma unroll
            for (int j = 0; j < 2; ++j) {
                const float a0 = __builtin_bit_cast(float, wa[j] << 16), a1 = __builtin_bit_cast(float, wa[j] & 0xffff0000u);
                const float b0 = __builtin_bit_cast(float, wb[j] << 16), b1 = __builtin_bit_cast(float, wb[j] & 0xffff0000u);
                if (g < 2) { o0[8 * g + 2 * j] = o0[8 * g + 2 * j] * an + a0 * ao; o0[8 * g + 2 * j + 1] = o0[8 * g + 2 * j + 1] * an + a1 * ao;
                             o0[8 * g + 4 + 2 * j] = o0[8 * g + 4 + 2 * j] * an + b0 * ao; o0[8 * g + 4 + 2 * j + 1] = o0[8 * g + 4 + 2 * j + 1] * an + b1 * ao; }
                else { const int e = 8 * (g - 2);
                       o1[e + 2 * j] = o1[e + 2 * j] * an + a0 * ao; o1[e + 2 * j + 1] = o1[e + 2 * j + 1] * an + a1 * ao;
                       o1[e + 4 + 2 * j] = o1[e + 4 + 2 * j] * an + b0 * ao; o1[e + 4 + 2 * j + 1] = o1[e + 4 + 2 * j + 1] * an + b1 * ao; }
            }
        }
    }
    float sc = 1.f; bf16* dst = op;
    if (brmode != 2) { if (h == 0) gst<f32x2v>(MLh + 2 * (size_t)qpos, (f32x2v){mrun, lrun}); }
    else { sc = 1.f / lrun; dst = outp + (size_t)qpos * 1024 + 8 * h; }
#pragma unroll
    for (int g = 0; g < 4; ++g) {
        unsigned ax, ay, bx, by;
        if (g < 2) { ax = pk2(o0[8 * g] * sc, o0[8 * g + 1] * sc); ay = pk2(o0[8 * g + 2] * sc, o0[8 * g + 3] * sc); bx = pk2(o0[8 * g + 4] * sc, o0[8 * g + 5] * sc); by = pk2(o0[8 * g + 6] * sc, o0[8 * g + 7] * sc); }
        else { const int e = 8 * (g - 2); ax = pk2(o1[e] * sc, o1[e + 1] * sc); ay = pk2(o1[e + 2] * sc, o1[e + 3] * sc); bx = pk2(o1[e + 4] * sc, o1[e + 5] * sc); by = pk2(o1[e + 6] * sc, o1[e + 7] * sc); }
        const auto rx = __builtin_amdgcn_permlane32_swap(ax, bx, false, false);
        const auto ry = __builtin_amdgcn_permlane32_swap(ay, by, false, false);
        gst<v4u>(dst + 16 * g, (v4u){rx[0], ry[0], rx[1], ry[1]});
    }
}

__device__ __forceinline__ void att_phase(unsigned char* ws, LAS unsigned char* lds, int lane, int wave, int G) {
    const bf16* Qa = (const bf16*)(ws + WS_BIG); const bf16* Ka = Qa + SEG; const bf16* Va = Qa + 2 * SEG;
    float* OP = (float*)(ws + WS_OP); float* ML = (float*)(ws + WS_ML); bf16* MO = (bf16*)(ws + WS_H);
    LAS unsigned char* vlds = lds + wave * 16384;
    const int nun = G == 256 ? 2 : (512 + G - 1) / G;
    const int qc = lane & 31, h = lane >> 5;
    const int i16 = lane & 15, tq = i16 >> 2, tp = i16 & 3, blk = (lane >> 4) & 1;
    LAS const unsigned char* trb = vlds + (4 * h + tq) * VP + (16 * blk) * 2 + 8 * tp;
    bf16x8 qfA[4], qfB[4];
#define ATT_DMA_KV(J, kb, slot) do { _Pragma("unroll") for (int i_ = 0; i_ < 4; ++i_) { const int key_ = 8 * i_ + (lane >> 3); int kp_ = (J).pos0 + (32 * (kb) + key_ - 128) * (J).d; kp_ = kp_ < 0 ? 0 : kp_; \
        __builtin_amdgcn_global_load_lds((const GAS unsigned*)(Ka + ((J).hb + (size_t)kp_) * 64 + (((lane & 7) ^ ((lane >> 3) & 7)) * 8)), (LAS unsigned*)(vlds + (slot) * 4096 + i_ * 1024), 16, 0, 0); \
        __builtin_amdgcn_global_load_lds((const GAS unsigned*)(Va + ((J).hb + (size_t)kp_) * 64 + (lane & 7) * 8), (LAS unsigned*)(vlds + 8192 + (slot) * 4096 + i_ * 1024), 16, 0, 0); } } while (0)
#define ATT_LOAD_Q(dst, J, set) do { const int qp_ = (J).pos0 + (32 * (set) + qc) * (J).d; _Pragma("unroll") for (int kk_ = 0; kk_ < 4; ++kk_) dst[kk_] = gld<bf16x8>(Qa + ((J).hb + (size_t)qp_) * 64 + 8 * h + 16 * kk_); } while (0)
    LAS const unsigned char* kfb = vlds + qc * 128;
    AttJob P, N;
    bool have = att_params(0, nun, G, wave, P);
    int sb = 0;
    if (have) { ATT_DMA_KV(P, 0, 0); ATT_LOAD_Q(qfA, P, 0); ATT_LOAD_Q(qfB, P, 1); }
#pragma unroll 1
    for (int q = 0; have; ++q) {
        const bool hn = att_params(q + 1, nun, G, wave, N);
        const int pos0 = P.pos0, d = P.d, brmode = P.brmode;
        bf16* OPh = (bf16*)OP + P.hb * 64; float* MLh = ML + P.hb * 2; bf16* outp = MO + (size_t)P.b * SEQ * 1024 + P.head * 64;
        float mA = -1e30f, lA = 0.f, mB = -1e30f, lB = 0.f;
        f32x16 oA0, oA1, oB0, oB1;
#pragma unroll
        for (int i = 0; i < 16; ++i) { oA0[i] = 0.f; oA1[i] = 0.f; oB0[i] = 0.f; oB1[i] = 0.f; }
        int kminA = 0, kminB = 0;
        { const int t0 = 128 * d - pos0; if (t0 > 0) kminA = (t0 + d - 1) / d; const int t1 = 96 * d - pos0; if (t1 > 0) kminB = (t1 + d - 1) / d; }
        const int mloA = qc > kminA ? qc : kminA, mloB = qc > kminB ? qc : kminB;
#pragma unroll
        for (int kb = 0; kb < 6; ++kb) {
            asm volatile("s_waitcnt vmcnt(0)" ::: "memory");
            if (kb < 5) ATT_DMA_KV(P, kb + 1, sb ^ 1);
            else if (hn) ATT_DMA_KV(N, 0, sb ^ 1);
            bf16x8 kf[4], va[4];
#pragma unroll
            for (int kk = 0; kk < 4; ++kk) kf[kk] = *(LAS const bf16x8*)(kfb + sb * 4096 + (((2 * kk + h) ^ (qc & 7)) << 4));
            LAS const unsigned char* trs = trb + 8192 + sb * 4096;
#pragma unroll
            for (int s = 0; s < 2; ++s) {
                const s16x4 lo0 = vtr(trs + (16 * s) * VP), hi0 = vtr(trs + (16 * s + 8) * VP);
                const s16x4 lo1 = vtr(trs + (16 * s) * VP + 64), hi1 = vtr(trs + (16 * s + 8) * VP + 64);
                va[2 * s] = (bf16x8){lo0[0], lo0[1], lo0[2], lo0[3], hi0[0], hi0[1], hi0[2], hi0[3]};
                va[2 * s + 1] = (bf16x8){lo1[0], lo1[1], lo1[2], lo1[3], hi1[0], hi1[1], hi1[2], hi1[3]};
            }
            if (kb <= 4) {
                att_block(kf, qfA, va, oA0, oA1, mA, lA, kb == 0 || kb == 4 || kminA > 32 * kb, mloA - 4 * h - 32 * kb, qc + 128 - 4 * h - 32 * kb);
                if (kb == 4 && hn) ATT_LOAD_Q(qfA, N, 0);
            }
            if (kb >= 1) {
                att_block(kf, qfB, va, oB0, oB1, mB, lB, kb == 1 || kb == 5 || kminB > 32 * (kb - 1), mloB - 4 * h - 32 * (kb - 1), qc + 128 - 4 * h - 32 * (kb - 1));
                if (kb == 5 && hn) ATT_LOAD_Q(qfB, N, 1);
            }
            LDS_WAIT();
            sb ^= 1;
            __builtin_amdgcn_sched_barrier(0);
        }
        att_merge(oA0, oA1, mA, lA, pos0 + qc * d, brmode, OPh, MLh, outp, h);
        att_merge(oB0, oB1, mB, lB, pos0 + (32 + qc) * d, brmode, OPh, MLh, outp, h);
        if (P.bar_after) { asm volatile("s_waitcnt vmcnt(0) lgkmcnt(0)" ::: "memory"); __syncthreads(); __builtin_amdgcn_fence(__ATOMIC_ACQUIRE, "agent"); }
        P = N; have = hn;
    }
#undef ATT_DMA_KV
#undef ATT_LOAD_Q
}

constexpr int RAWP = 272, KTP = 144;
__device__ __forceinline__ void hg_fetch(const bf16* src, int tok0, int hh, int tid, v4u (&r)[2]) {
#pragma unroll
    for (int i = 0; i < 2; ++i) { const int idx = tid + 512 * i, row = idx >> 4, ch = idx & 15;
        r[i] = gld<v4u>(src + (size_t)(tok0 + row) * 512 + hh * 128 + ch * 8); }
}
__device__ __forceinline__ void hg_put(const v4u (&r)[2], LAS unsigned char* dst, int tid) {
#pragma unroll
    for (int i = 0; i < 2; ++i) { const int idx = tid + 512 * i, row = idx >> 4, ch = idx & 15; *(LAS v4u*)(dst + row * RAWP + ch * 16) = r[i]; }
}
__device__ __forceinline__ void hg_job(int job, int& hh, int& tok0) { const int bh = job >> 7, ch = job & 127; hh = bh & 3; tok0 = (bh >> 2) * SEQ + ch * 64; }
__device__ __forceinline__ void hg_decay(LAS const unsigned char* rawF, LAS float* part, float lbc, int c, int j, float (&bc)[16], float (&kv)[16], float& tot, float& bref) {
    float run = 0.f;
#pragma unroll
    for (int i = 0; i < 16; ++i) { const float lf = h2f(*(LAS const unsigned short*)(rawF + (16 * j + i) * RAWP + 2 * c)); kv[i] = 1.f - __expf(lf); run += lf; bc[i] = run; }
    part[j * 128 + c] = run;
    __syncthreads();
    const float p0 = part[c], p1 = part[128 + c], p2 = part[256 + c], p3 = part[384 + c];
    const float pre = j == 0 ? 0.f : (j == 1 ? p0 : (j == 2 ? p0 + p1 : p0 + p1 + p2));
#pragma unroll
    for (int i = 0; i < 16; ++i) bc[i] += pre;
    tot = (p0 + p1) + (p2 + p3); bref = p0 + p1;
}
__device__ __forceinline__ void st16bf(LAS unsigned char* p, const float (&v)[16]) {
    v4u a, b; a.x = pk2(v[0], v[1]); a.y = pk2(v[2], v[3]); a.z = pk2(v[4], v[5]); a.w = pk2(v[6], v[7]);
    b.x = pk2(v[8], v[9]); b.y = pk2(v[10], v[11]); b.z = pk2(v[12], v[13]); b.w = pk2(v[14], v[15]);
    *(LAS v4u*)p = a; *(LAS v4u*)(p + 16) = b;
}

__device__ __forceinline__ void hgrn1_phase(unsigned char* ws, const float* lbl, LAS unsigned char* lds, int tid, int lane, int wave, int G) {
    const bf16* HF = (const bf16*)(ws + WS_BIG) + 4 * SEG; const bf16* HI = (const bf16*)(ws + WS_BIG) + 5 * SEG;
    bf16* DS = (bf16*)(ws + WS_DS); float* HDEC = (float*)(ws + WS_HDEC);
    LAS unsigned char* rawF = lds; LAS unsigned char* rawI = lds + 17408; LAS unsigned char* KT = lds + 34816; LAS unsigned char* VT = KT + 18432; LAS float* part = (LAS float*)(VT + 18432);
    const int c = tid & 127, j = tid >> 7, fr = lane & 15, fq = lane >> 4;
    v4u rF[2], rI[2];
    { int hh0, t0; hg_job(blockIdx.x, hh0, t0); if ((int)blockIdx.x < 4096) { hg_fetch(HF, t0, hh0, tid, rF); hg_fetch(HI, t0, hh0, tid, rI); } }
    for (int job = blockIdx.x; job < 4096; job += G) {
        int hh, tok0; hg_job(job, hh, tok0);
        hg_put(rF, rawF, tid); hg_put(rI, rawI, tid);
        __syncthreads();
        if (job + G < 4096) { int hn, tn; hg_job(job + G, hn, tn); hg_fetch(HF, tn, hn, tid, rF); hg_fetch(HI, tn, hn, tid, rI); }
        float bc[16], kv[16], tot, bref;
        hg_decay(rawF, part, lbl[hh * 128 + c], c, j, bc, kv, tot, bref);
        float tmp[16];
#pragma unroll
        for (int i = 0; i < 16; ++i) tmp[i] = kv[i] * __expf(tot - bc[i]);
        st16bf(KT + c * KTP + j * 32, tmp);
#pragma unroll
        for (int i = 0; i < 16; ++i) tmp[i] = bf2f(*(LAS const unsigned short*)(rawI + (16 * j + i) * RAWP + 2 * c));
        st16bf(VT + c * KTP + j * 32, tmp);
        if (j == 0) gst<float>(HDEC + (size_t)job * 128 + c, __expf(tot));
        __syncthreads();
        bf16x8 af[2];
#pragma unroll
        for (int kk = 0; kk < 2; ++kk) af[kk] = *(LAS const bf16x8*)(KT + (16 * wave + fr) * KTP + (8 * fq + 32 * kk) * 2);
#pragma unroll
        for (int n = 0; n < 8; ++n) {
            f32x4 cacc = (f32x4){0.f, 0.f, 0.f, 0.f};
#pragma unroll
            for (int kk = 0; kk < 2; ++kk) { const bf16x8 bfr = *(LAS const bf16x8*)(VT + (16 * n + fr) * KTP + (8 * fq + 32 * kk) * 2);
                cacc = __builtin_amdgcn_mfma_f32_16x16x32_bf16(af[kk], bfr, cacc, 0, 0, 0); }
            v2u w; w.x = pk2(cacc[0], cacc[1]); w.y = pk2(cacc[2], cacc[3]);
            gst<v2u>(DS + (size_t)job * 16384 + (n * 4 + (wave >> 1)) * 512 + (fr + 16 * (2 * (wave & 1) + (fq >> 1))) * 8 + 4 * (fq & 1), w);
        }
        __syncthreads();
    }
}

__device__ __forceinline__ void hgrn2_phase(unsigned char* ws, int tid, int G) {
    bf16* DS = (bf16*)(ws + WS_DS); const float* HDEC = (const float*)(ws + WS_HDEC);
    for (int gt = blockIdx.x * 512 + tid; gt < 32 * 4096; gt += G * 512) {
        const int bh = gt >> 12, e4 = gt & 4095; const int lin = 4 * e4, dk = 32 * ((lin >> 9) & 3) + 8 * (((lin & 511) >> 3) >> 4) + (lin & 7);
        bf16* p = DS + (size_t)bh * 128 * 16384 + 4 * e4; const float* dp = HDEC + (size_t)bh * 128 * 128 + dk;
        f32x4 s = (f32x4){0.f, 0.f, 0.f, 0.f};
#pragma unroll 1
        for (int c0 = 0; c0 < 128; c0 += 16) {
            v2u w[16]; f32x4 dc[16];
#pragma unroll
            for (int i = 0; i < 16; ++i) { w[i] = gld<v2u>(p + (size_t)(c0 + i) * 16384); dc[i] = gld<f32x4>(dp + (c0 + i) * 128); }
#pragma unroll
            for (int i = 0; i < 16; ++i) {
                v2u o; o.x = pk2(s.x, s.y); o.y = pk2(s.z, s.w); gst<v2u>(p + (size_t)(c0 + i) * 16384, o);
                const f32x4 dv = (f32x4){__builtin_bit_cast(float, w[i].x << 16), __builtin_bit_cast(float, w[i].x & 0xffff0000u), __builtin_bit_cast(float, w[i].y << 16), __builtin_bit_cast(float, w[i].y & 0xffff0000u)};
                s = dc[i] * s + dv;
            }
        }
    }
}

__device__ __forceinline__ void hgrn3_phase(unsigned char* ws, const float* lbl, const float* nw, LAS unsigned char* lds, int tid, int lane, int wave, int G) {
    const bf16* HQ = (const bf16*)(ws + WS_BIG) + 3 * SEG; const bf16* HF = HQ + SEG; const bf16* HI = HQ + 2 * SEG; const bf16* HG = HQ + 3 * SEG;
    const bf16* DS = (const bf16*)(ws + WS_DS); bf16* MO = (bf16*)(ws + WS_H);
    LAS unsigned char* rawQ = lds; LAS unsigned char* rawF = lds + 17408; LAS unsigned char* rawI = lds + 2 * 17408;
    LAS unsigned char* QT = lds + 3 * 17408; LAS unsigned char* KT = QT + 17408; LAS unsigned char* QH = KT + 17408;
    LAS unsigned char* VT = QH + 17408;
    LAS unsigned char* PT = VT + 18432;
    LAS float* part = (LAS float*)(PT + 9216);
    LAS float* ssq = part + 512;
    const int c = tid & 127, j = tid >> 7, fr = lane & 15, fq = lane >> 4;
    const int tt = wave >> 1, wh = wave & 1;
    v4u rQ[2], rF[2], rI[2];
    { int hh0, t0; hg_job(blockIdx.x, hh0, t0); if ((int)blockIdx.x < 4096) { hg_fetch(HQ, t0, hh0, tid, rQ); hg_fetch(HF, t0, hh0, tid, rF); hg_fetch(HI, t0, hh0, tid, rI); } }
    for (int job = blockIdx.x; job < 4096; job += G) {
        int hh, tok0; hg_job(job, hh, tok0);
        hg_put(rQ, rawQ, tid); hg_put(rF, rawF, tid); hg_put(rI, rawI, tid);
        bf16x8 sf[4][4];
#pragma unroll
        for (int n = 0; n < 4; ++n)
#pragma unroll
            for (int kk = 0; kk < 4; ++kk) sf[n][kk] = gld<bf16x8>(DS + (size_t)job * 16384 + ((4 * wh + n) * 4 + kk) * 512 + lane * 8);
        __syncthreads();
        if (job + G < 4096) { int hn, tn; hg_job(job + G, hn, tn); hg_fetch(HQ, tn, hn, tid, rQ); hg_fetch(HF, tn, hn, tid, rF); hg_fetch(HI, tn, hn, tid, rI); }
        {
            float bc[16], kv[16], tot, bref;
            hg_decay(rawF, part, lbl[hh * 128 + c], c, j, bc, kv, tot, bref);
#pragma unroll
            for (int i = 0; i < 16; ++i) {
                const int t = 16 * j + i;
                const float q = bf2f(*(LAS const unsigned short*)(rawQ + t * RAWP + 2 * c));
                const float dq = fminf(fmaxf(bc[i] - bref, -80.f), 80.f);
                *(LAS unsigned short*)(QT + t * RAWP + 2 * c) = (unsigned short)pk2(q * __expf(dq), 0.f);
                *(LAS unsigned short*)(KT + t * RAWP + 2 * c) = (unsigned short)pk2(kv[i] * __expf(-dq), 0.f);
                *(LAS unsigned short*)(QH + t * RAWP + 2 * c) = (unsigned short)pk2(q * __expf(bc[i]), 0.f);
            }
            float tmp[16];
#pragma unroll
            for (int i = 0; i < 16; ++i) tmp[i] = bf2f(*(LAS const unsigned short*)(rawI + (16 * j + i) * RAWP + 2 * c));
            st16bf(VT + c * KTP + j * 32, tmp);
        }
        __syncthreads();
        {
            bf16x8 qfr[4];
#pragma unroll
            for (int kk = 0; kk < 4; ++kk) qfr[kk] = *(LAS const bf16x8*)(QT + (16 * tt + fr) * RAWP + (8 * fq + 32 * kk) * 2);
#pragma unroll
            for (int si = 0; si < 2; ++si) {
                const int stile = 2 * wh + si;
                f32x4 cacc = (f32x4){0.f, 0.f, 0.f, 0.f};
#pragma unroll
                for (int kk = 0; kk < 4; ++kk) { const bf16x8 kfr = *(LAS const bf16x8*)(KT + (16 * stile + fr) * RAWP + (8 * fq + 32 * kk) * 2);
                    cacc = __builtin_amdgcn_mfma_f32_16x16x32_bf16(kfr, qfr[kk], cacc, 0, 0, 0); }
                const int t = 16 * tt + fr, s0 = 16 * stile + 4 * fq;
#pragma unroll
                for (int i = 0; i < 4; ++i) cacc[i] = (s0 + i <= t) ? cacc[i] : 0.f;
                v2u w; w.x = pk2(cacc[0], cacc[1]); w.y = pk2(cacc[2], cacc[3]);
                *(LAS v2u*)(PT + t * KTP + s0 * 2) = w;
            }
        }
        __syncthreads();
        v2u gpre[4];
#pragma unroll
        for (int n = 0; n < 4; ++n) gpre[n] = gld<v2u>(HG + (size_t)(tok0 + 16 * tt + fr) * 512 + hh * 128 + 16 * (4 * wh + n) + 4 * fq);
        f32x4 oacc[4];
        {
            bf16x8 pfr[2], qh[4];
#pragma unroll
            for (int kk = 0; kk < 2; ++kk) pfr[kk] = *(LAS const bf16x8*)(PT + (16 * tt + fr) * KTP + (8 * fq + 32 * kk) * 2);
#pragma unroll
            for (int kk = 0; kk < 4; ++kk) qh[kk] = *(LAS const bf16x8*)(QH + (16 * tt + fr) * RAWP + (8 * fq + 32 * kk) * 2);
#pragma unroll
            for (int n = 0; n < 4; ++n) {
                f32x4 cacc = (f32x4){0.f, 0.f, 0.f, 0.f};
#pragma unroll
                for (int kk = 0; kk < 2; ++kk) { const bf16x8 vfr = *(LAS const bf16x8*)(VT + (16 * (4 * wh + n) + fr) * KTP + (8 * fq + 32 * kk) * 2);
                    cacc = __builtin_amdgcn_mfma_f32_16x16x32_bf16(vfr, pfr[kk], cacc, 0, 0, 0); }
#pragma unroll
                for (int kk = 0; kk < 4; ++kk) cacc = __builtin_amdgcn_mfma_f32_16x16x32_bf16(sf[n][kk], qh[kk], cacc, 0, 0, 0);
                oacc[n] = cacc;
            }
        }
        float sq = 0.f;
#pragma unroll
        for (int n = 0; n < 4; ++n) sq += (oacc[n][0] * oacc[n][0] + oacc[n][1] * oacc[n][1]) + (oacc[n][2] * oacc[n][2] + oacc[n][3] * oacc[n][3]);
        sq += __shfl_xor(sq, 16); sq += __shfl_xor(sq, 32);
        if (fq == 0) ssq[wh * 64 + 16 * tt + fr] = sq;
        __syncthreads();
        {
            const int t = 16 * tt + fr;
            const float rinv = 1.f / sqrtf((ssq[t] + ssq[64 + t]) * (1.f / 128.f) + RMS_EPS);
#pragma unroll
            for (int n = 0; n < 4; ++n) {
                const int dv = 16 * (4 * wh + n) + 4 * fq;
                const f32x4 nwv = gld<f32x4>(nw + hh * 128 + dv);
                const v2u gw_ = gpre[n];
                const f32x4 gv = (f32x4){__builtin_bit_cast(float, gw_.x << 16), __builtin_bit_cast(float, gw_.x & 0xffff0000u), __builtin_bit_cast(float, gw_.y << 16), __builtin_bit_cast(float, gw_.y & 0xffff0000u)};
                const f32x4 ov = oacc[n] * rinv * nwv * gv;
                v2u w; w.x = pk2(ov[0], ov[1]); w.y = pk2(ov[2], ov[3]);
                gst<v2u>(MO + (size_t)(tok0 + t) * 1024 + 512 + hh * 128 + dv, w);
            }
        }
        __syncthreads();
    }
}

__device__ __forceinline__ void grid_bar(unsigned* ctrs, unsigned gen, int tid, unsigned G) {
    asm volatile("s_waitcnt vmcnt(0) lgkmcnt(0)" ::: "memory");
    __syncthreads();
    if (tid == 0) {
        __builtin_amdgcn_fence(__ATOMIC_RELEASE, "agent");
        if ((G & 7u) == 0u) {
            const unsigned g = blockIdx.x & 7u, gs = G >> 3;
            const unsigned old = __hip_atomic_fetch_add(ctrs + 64 * (1 + g), 1u, __ATOMIC_RELAXED, __HIP_MEMORY_SCOPE_AGENT);
            if (old + 1u == gen * gs) __hip_atomic_fetch_add(ctrs, 1u, __ATOMIC_RELAXED, __HIP_MEMORY_SCOPE_AGENT);
            while (__hip_atomic_load(ctrs, __ATOMIC_RELAXED, __HIP_MEMORY_SCOPE_AGENT) < gen * 8u) __builtin_amdgcn_s_sleep(1);
        } else {
            __hip_atomic_fetch_add(ctrs, 1u, __ATOMIC_RELAXED, __HIP_MEMORY_SCOPE_AGENT);
            while (__hip_atomic_load(ctrs, __ATOMIC_RELAXED, __HIP_MEMORY_SCOPE_AGENT) < gen * G) __builtin_amdgcn_s_sleep(1);
        }
        __builtin_amdgcn_fence(__ATOMIC_ACQUIRE, "agent");
    }
    __syncthreads();
}
constexpr int N_PHASES = 26;
__global__ void __launch_bounds__(512, 2) mk_fwd(Args a) {
    extern __shared__ __attribute__((aligned(16))) unsigned char lds_raw[];
    LAS unsigned char* lds = (LAS unsigned char*)lds_raw;
    int rep = 0; unsigned nbar = 0u;
    const int wave_s = __builtin_amdgcn_readfirstlane((int)threadIdx.x >> 6);
    for (int ph = a.ph_lo; ph < a.ph_hi; ++ph) {
        int tid; { int ln_; asm volatile("v_mbcnt_lo_u32_b32 %0, -1, 0\n\tv_mbcnt_hi_u32_b32 %0, -1, %0" : "=v"(ln_)); tid = wave_s * 64 + ln_; }
        int G = gridDim.x; asm volatile("" : "+s"(G));
        int bid = blockIdx.x; asm volatile("" : "+s"(bid));
        unsigned char* ws = a.ws; asm volatile("" : "+s"(ws));
        float* outp = a.out; asm volatile("" : "+s"(outp));
        const float* xin = (const float*)a.in[0]; asm volatile("" : "+s"(xin));
        const float* ln_g = (const float*)a.in[3]; asm volatile("" : "+s"(ln_g));
        const float* ln_b = (const float*)a.in[4]; asm volatile("" : "+s"(ln_b));
        const int wave = wave_s;
#define LANE_() ({ int l_ = tid & 63; asm volatile("" : "+v"(l_)); l_; })
        float* ada = (float*)(ws + WS_ADA); float* stats = (float*)(ws + WS_STATS);
        bf16* Hb = (bf16*)(ws + WS_H); bf16* ACT = (bf16*)(ws + WS_BIG);
        const int l = ph < 2 ? 0 : (ph - 2) / 12, k = ph < 2 ? ph : 2 + (ph - 2) % 12;
        unsigned char* wl = ws + WS_W + (size_t)l * W_LAYER;
        const float* ada_l = ada + (size_t)l * 8 * NADA;
#ifdef PHMASK
        if (!((PHMASK >> k) & 1)) continue;
#endif
#ifndef SKIPMASK
#define SKIPMASK 0x0
#endif
        if ((SKIPMASK >> k) & 1) continue;
        switch (k) {
        case 0: prologue_phase(a, lds, tid, LANE_(), wave, G); break;
        case 1: lnmod_phase<0>(xin, nullptr, nullptr, Hb, nullptr, nullptr, ada, LANE_(), wave, G); break;
        case 2: case 11: {
            pg8::Gemm g{Hb, (const bf16*)(wl + (k == 2 ? W_1IN : W_2IN)), M, 2 * FF, D}; pg8::StaticOrder S; S.init(M, 2 * FF, G, bid);
            pg8::EpiSwiglu E{ACT, FF};
            pg8::gemm_phase<pg8::EpiSwiglu, pg8::StaticOrder, true, true>(lds, g, S, E, tid);
        } break;
        case 3: case 9: case 12: {
            const int sub = k == 3 ? 0 : (k == 9 ? 1 : 2);
            const bf16* A = k == 9 ? Hb : ACT; const int K = k == 9 ? D : FF;
            const bf16* Bt = (const bf16*)(wl + (k == 3 ? W_1OUT : (k == 9 ? W_MOUT : W_2OUT)));
            const int mode = (l == 0 && sub == 0) ? 0 : 1;
            const int pl = sub == 0 ? l - 1 : l, ps = sub == 0 ? 2 : sub - 1;
            const int pidx = mode ? (pl * 3 + ps) : 0;
            pg8::Gemm g{A, Bt, M, D, K}; pg8::StaticOrder S; S.init(M, D, G, bid);
            pg8::EpiResid E{xin, outp, stats, ln_g + pidx * D, ln_b + pidx * D, ada_l + sub * 3072 + 2048, DN_ALPHA, sub == 1 ? 1.0f : 0.5f, mode, (unsigned)(size_t)(lds + 131072)};
            pg8::gemm_phase<pg8::EpiResid, pg8::StaticOrder, true, true>(lds, g, S, E, tid);
        } break;
        case 4: case 10: case 13: {
            const int sub = k == 4 ? 0 : (k == 10 ? 1 : 2);
            const float* lg = ln_g + (l * 3 + sub) * D; const float* lb = ln_b + (l * 3 + sub) * D;
            if (k == 13 && l == 1) lnmod_phase<2>(outp, outp, nullptr, nullptr, lg, lb, nullptr, LANE_(), wave, G);
            else { const float* am = k == 13 ? ada + (size_t)(l + 1) * 8 * NADA : ada_l + (sub + 1) * 3072;
                lnmod_phase<1>(outp, nullptr, stats, Hb, lg, lb, am, LANE_(), wave, G); }
        } break;
        case 5: {
            pg8::Gemm g{Hb, (const bf16*)(wl + W_MIN), M, NIN, D}; pg8::StaticOrder S; S.init(M, NIN, G, bid);
            pg8::EpiMixIn E{(bf16*)(ws + WS_BIG), (const float*)(ws + WS_ROPE), (const float*)(ws + WS_LB) + l * 512};
            pg8::gemm_phase<pg8::EpiMixIn, pg8::StaticOrder, true, true>(lds, g, S, E, tid);
        } break;
#ifndef SKIP_ATT
#define SKIP_ATT 0
#endif
        case 6: { if (!SKIP_ATT) att_phase(ws, lds, LANE_(), wave, G); __syncthreads();
                int tid2; { int ln2_; asm volatile("v_mbcnt_lo_u32_b32 %0, -1, 0\n\tv_mbcnt_hi_u32_b32 %0, -1, %0" : "=v"(ln2_)); tid2 = wave_s * 64 + ln2_; }
            unsigned char* ws2 = a.ws; asm volatile("" : "+s"(ws2));
            hgrn1_phase(ws2, (const float*)(ws2 + WS_LB) + l * 512, lds, tid2, tid2 & 63, wave_s, G); } break;
        case 7: hgrn2_phase(ws, tid, G); break;
        case 8: hgrn3_phase(ws, (const float*)(ws + WS_LB) + l * 512, (const float*)a.in[13] + l * 512, lds, tid, LANE_(), wave, G); break;
        default: break;
        }
#ifndef REPMASK
#define REPMASK 0
#endif
        if (((REPMASK >> k) & 1) && rep == 0 && !(k == 13 && l == 1)) { rep = 1; --ph; } else rep = 0;
        if (ph + 1 < a.ph_hi) {
            if (nbar == 0u) { cg::this_grid().sync(); nbar = 1u; }
            else { grid_bar((unsigned*)(a.ws + WS_LB + 8192), nbar, tid, gridDim.x); ++nbar; }
        }
    }
}

#ifndef MK_PER_PHASE
#define MK_PER_PHASE 0
#endif
extern "C" void kernel_launch(void* const* d_in, const int* in_sizes, int n_in, void* d_out, int out_size, void* d_ws, size_t ws_size, hipStream_t stream) {
    static int grid = 0;
    if (grid == 0) {
        if (n_in != 15 || in_sizes[0] != M * D || out_size != M * D || ws_size < WS_END) {
            fprintf(stderr, "kernel_launch: unexpected shapes (n_in %d, in0 %d, out %d, ws %zu, need %zu)\n", n_in, n_in > 0 ? in_sizes[0] : -1, out_size, ws_size, (size_t)WS_END); grid = -1; return; }
        int dev = 0, cus = 0, per_cu = 0;
        hipGetDevice(&dev); hipDeviceGetAttribute(&cus, hipDeviceAttributeMultiprocessorCount, dev);
        hipFuncSetAttribute((const void*)mk_fwd, hipFuncAttributeMaxDynamicSharedMemorySize, LDS_BYTES);
        hipOccupancyMaxActiveBlocksPerMultiprocessor(&per_cu, (const void*)mk_fwd, 512, LDS_BYTES);
        if (per_cu < 1) { fprintf(stderr, "kernel_launch: occupancy query says %d blocks per CU\n", per_cu); per_cu = 1; }
        (void)hipGetLastError();
        grid = cus * 1;
    }
    if (grid < 0) return;
    Args a{};
    for (int i = 0; i < 15; ++i) a.in[i] = d_in[i];
    a.out = (float*)d_out; a.ws = (unsigned char*)d_ws;
    for (int j = 0; j < 8; ++j) a.invf[j] = (float)std::pow(500000.0, -(double)j / 8.0);
#if MK_PER_PHASE
    for (int ph = 0; ph < N_PHASES; ++ph) { a.ph_lo = ph; a.ph_hi = ph + 1; hipLaunchKernelGGL(mk_fwd, dim3(grid), dim3(512), LDS_BYTES, stream, a); }
#else
    a.ph_lo = 0; a.ph_hi = N_PHASES;
    void* args[] = {&a};
    hipError_t e = hipLaunchCooperativeKernel((const void*)mk_fwd, dim3(grid), dim3(512), args, LDS_BYTES, stream);
    if (e != hipSuccess) fprintf(stderr, "cooperative launch failed: %s (grid %d)\n", hipGetErrorString(e), grid);
#endif
}
```
